# Optimizing an MI355X kernel written in HIP

```python
import math
import jax, jax.numpy as jnp
from jax import lax
import numpy as np

D_MODEL = 1024
BATCH = 32
SEQ = 2048
DEPTH = 1

CHUNK = 64
QBLOCK = 128
HEAD_DIM = 64
MIX_WIDTH = D_MODEL
A_HEADS = 4
A_WIDTH = A_HEADS * 2 * HEAD_DIM
B_HEADS = 8
B_WIDTH = B_HEADS * HEAD_DIM
IN_WIDTH = 6 * 512
D_FF = ((8 * D_MODEL // 3 + 255) // 256) * 256
PLE_DIM = 256
ROPE_THETA = 10000.0
LN_EPS = 1e-5
DEEPNORM_ALPHA = (2.0 * DEPTH) ** 0.25
DEEPNORM_BETA = (8.0 * DEPTH) ** -0.25

kernel_name = "hymba_diff_stickbreak_deepnorm_encoder"


def layer_norm(x, g, b):
    xf = x.astype(jnp.float32)
    mu = jnp.mean(xf, axis=-1, keepdims=True)
    var = jnp.mean(jnp.square(xf - mu), axis=-1, keepdims=True)
    y = (xf - mu) * lax.rsqrt(var + LN_EPS)
    return (y * g.astype(jnp.float32) + b.astype(jnp.float32)).astype(x.dtype)


def rms_norm(x, g):
    xf = x.astype(jnp.float32)
    y = xf * lax.rsqrt(jnp.mean(jnp.square(xf), axis=-1, keepdims=True) + LN_EPS)
    return y * g.astype(jnp.float32)


def rope_tables(seq_len):
    inv_freq = 1.0 / (ROPE_THETA ** (jnp.arange(0, HEAD_DIM, 2, dtype=jnp.float32) / HEAD_DIM))
    ang = jnp.arange(seq_len, dtype=jnp.float32)[:, None] * inv_freq[None, :]
    ang = jnp.concatenate([ang, ang], axis=-1)
    return jnp.cos(ang), jnp.sin(ang)


def apply_rope(t, cos, sin):
    tf = t.astype(jnp.float32)
    t1, t2 = jnp.split(tf, 2, axis=-1)
    rot = jnp.concatenate([-t2, t1], axis=-1)
    return tf * cos[None, :, None, :] + rot * sin[None, :, None, :]


def differential_attention(q, k, v, lam):
    S = q.shape[1]
    scale = 1.0 / math.sqrt(HEAD_DIM)
    vf = v.astype(jnp.float32)
    outs = []
    for blk in range(S // QBLOCK):
        t0, t1 = blk * QBLOCK, (blk + 1) * QBLOCK
        qpos = jnp.arange(t0, t1)
        kpos = jnp.arange(t1)
        mask = (qpos[:, None] // CHUNK) >= (kpos[None, :] // CHUNK)
        s = jnp.einsum('bqhmd,bkhmd->bhmqk', q[:, t0:t1], k[:, :t1]) * scale
        s = jnp.where(mask[None, None, None], s, -jnp.inf)
        pr = jax.nn.softmax(s, axis=-1)
        w = pr[:, :, 0] - lam * pr[:, :, 1]
        outs.append(jnp.einsum('bhqk,bkhe->bqhe', w, vf[:, :t1]))
    return jnp.concatenate(outs, axis=1)


def stick_breaking_attention(q, k, v):
    S = q.shape[1]
    scale = 1.0 / math.sqrt(HEAD_DIM)
    qf, kf, vf = q.astype(jnp.float32), k.astype(jnp.float32), v.astype(jnp.float32)
    outs = []
    for blk in range(S // QBLOCK):
        t0, t1 = blk * QBLOCK, (blk + 1) * QBLOCK
        qpos = jnp.arange(t0, t1)
        kpos = jnp.arange(t1)
        mask = (kpos[None, :] < qpos[:, None])[None, None]
        z = jnp.einsum('bqhd,bkhd->bhqk', qf[:, t0:t1], kf[:, :t1]) * scale
        log_beta = jax.nn.log_sigmoid(z)
        log_1m_beta = jnp.where(mask, -jax.nn.softplus(z), 0.0)
        suffix = lax.cumsum(log_1m_beta, axis=3, reverse=True) - log_1m_beta
        a = jnp.where(mask, jnp.exp(log_beta + suffix), 0.0)
        outs.append(jnp.einsum('bhqk,bkhd->bqhd', a, vf[:, :t1]))
    return jnp.concatenate(outs, axis=1)


def setup_inputs(seed: int = 0) -> dict:
    key = jax.random.key(seed)
    ks = jax.random.split(key, 24)
    f32 = jnp.float32
    nrm = lambda k, shape, s: jax.random.normal(k, shape, f32) * s
    gain = lambda k, shape: 1.0 + 0.02 * jax.random.normal(k, shape, f32)
    L, D = DEPTH, D_MODEL
    return {
        "x": jax.random.normal(ks[0], (BATCH, SEQ, D), f32),
        "p": jax.random.normal(ks[1], (DEPTH, BATCH, SEQ, PLE_DIM), f32),
        "ln_emb_g": gain(ks[2], (D,)),
        "ln_emb_b": nrm(ks[3], (D,), 0.02),
        "w_in": nrm(ks[4], (L, D, IN_WIDTH), D ** -0.5),
        "lam_q1": nrm(ks[5], (L, HEAD_DIM), 0.1),
        "lam_k1": nrm(ks[6], (L, HEAD_DIM), 0.1),
        "lam_q2": nrm(ks[7], (L, HEAD_DIM), 0.1),
        "lam_k2": nrm(ks[8], (L, HEAD_DIM), 0.1),
        "subln_g": gain(ks[9], (L, 2 * HEAD_DIM)),
        "w_out": nrm(ks[10], (L, MIX_WIDTH, D), DEEPNORM_BETA * MIX_WIDTH ** -0.5),
        "ln1_g": gain(ks[11], (L, D)),
        "ln1_b": nrm(ks[12], (L, D), 0.02),
        "w_ffn_gate": nrm(ks[13], (L, D, D_FF), D ** -0.5),
        "w_ffn_up": nrm(ks[14], (L, D, D_FF), D ** -0.5),
        "w_ffn_down": nrm(ks[15], (L, D_FF, D), DEEPNORM_BETA * D_FF ** -0.5),
        "ln2_g": gain(ks[16], (L, D)),
        "ln2_b": nrm(ks[17], (L, D), 0.02),
        "w_ple_gate": nrm(ks[18], (L, D, D), D ** -0.5),
        "b_ple_gate": nrm(ks[19], (L, D), 0.02),
        "w_ple_proj": nrm(ks[20], (L, PLE_DIM, D), DEEPNORM_BETA * PLE_DIM ** -0.5),
        "ln3_g": gain(ks[21], (L, D)),
        "ln3_b": nrm(ks[22], (L, D), 0.02),
    }


def reference(x, p, ln_emb_g, ln_emb_b, w_in, lam_q1, lam_k1, lam_q2, lam_k2, subln_g, w_out,
              ln1_g, ln1_b, w_ffn_gate, w_ffn_up, w_ffn_down, ln2_g, ln2_b,
              w_ple_gate, b_ple_gate, w_ple_proj, ln3_g, ln3_b):
    B, S, _ = x.shape
    cos, sin = rope_tables(S)
    h = layer_norm(x, ln_emb_g, ln_emb_b)
    for i in range(DEPTH):
        lambda_init = 0.8 - 0.6 * math.exp(-0.3 * i)
        proj = h @ w_in[i]
        aq, ak, av, bq, bk, bv = jnp.split(proj, 6, axis=-1)
        aq = apply_rope(aq.reshape(B, S, 2 * A_HEADS, HEAD_DIM), cos, sin).reshape(B, S, A_HEADS, 2, HEAD_DIM)
        ak = apply_rope(ak.reshape(B, S, 2 * A_HEADS, HEAD_DIM), cos, sin).reshape(B, S, A_HEADS, 2, HEAD_DIM)
        av = av.reshape(B, S, A_HEADS, 2 * HEAD_DIM)
        lam = (jnp.exp(jnp.sum(lam_q1[i].astype(jnp.float32) * lam_k1[i].astype(jnp.float32)))
               - jnp.exp(jnp.sum(lam_q2[i].astype(jnp.float32) * lam_k2[i].astype(jnp.float32)))
               + lambda_init)
        oa = differential_attention(aq, ak, av, lam)
        oa = rms_norm(oa, subln_g[i]) * (1.0 - lambda_init)
        ob = stick_breaking_attention(bq.reshape(B, S, B_HEADS, HEAD_DIM),
                                      bk.reshape(B, S, B_HEADS, HEAD_DIM),
                                      bv.reshape(B, S, B_HEADS, HEAD_DIM))
        mix = jnp.concatenate([oa.reshape(B, S, A_WIDTH), ob.reshape(B, S, B_WIDTH)], axis=-1).astype(h.dtype)
        h = layer_norm(DEEPNORM_ALPHA * h + mix @ w_out[i], ln1_g[i], ln1_b[i])
        f = (jax.nn.silu(h @ w_ffn_gate[i]) * (h @ w_ffn_up[i])) @ w_ffn_down[i]
        h = layer_norm(DEEPNORM_ALPHA * h + f, ln2_g[i], ln2_b[i])
        gate = jax.nn.sigmoid(h @ w_ple_gate[i] + b_ple_gate[i])
        e = p[i] @ w_ple_proj[i]
        h = layer_norm(DEEPNORM_ALPHA * h + gate * e, ln3_g[i], ln3_b[i])
    return h
```

```cpp
#include <hip/hip_runtime.h>
#include <hip/hip_cooperative_groups.h>
#include <cstdio>
#include <cstdint>
#include <cmath>
namespace cg = cooperative_groups;

constexpr int BATCH = 32, SEQ = 2048, DM = 1024, MTOK = BATCH * SEQ, NIN = 3072, DFF = 2816, NGU = 2 * DFF, PLE = 256;
constexpr float LN_EPS = 1e-5f, ALPHA = 1.189207115002721f, LAMBDA_INIT = 0.2f;
constexpr float QSCALE = 0.125f * 1.4426950408889634f;

__device__ __forceinline__ float shx(float v, int lane, int mask) { return __builtin_bit_cast(float, __builtin_amdgcn_ds_bpermute((lane ^ mask) << 2, __builtin_bit_cast(int, v))); }

constexpr size_t MiB = 1u << 20;
constexpr size_t WS_ST0 = 0, WS_ST1 = 512 * 1024, WS_ST2 = 1024 * 1024, WS_CS = 1536 * 1024;
constexpr int CS_IN = 0, BW_IN = 3072, CS_GU = 6144, BW_GU = 6144 + 5632, CS_PG = 6144 + 11264, BW_PG = CS_PG + 1024;
constexpr size_t WS_BAR = 1792 * 1024;
constexpr size_t WS_WIN = 2 * MiB, WS_WOUT = 8 * MiB, WS_WGU = 10 * MiB, WS_WDN = 21 * MiB, WS_WPG = 27 * MiB, WS_WPP = 29 * MiB, WS_ROPE = 30 * MiB;
constexpr size_t WS_ST3 = 832 * MiB;
constexpr size_t WS_XN = 32 * MiB, WS_QKV = 160 * MiB, WS_HID = 160 * MiB  , WS_MIX = 544 * MiB, WS_PB = 672 * MiB, WS_E = 704 * MiB, WS_END = 833 * MiB;
constexpr size_t WS_TBL = 1808 * 1024;

namespace pg8 {
#define PG8_LAS __attribute__((address_space(3)))
typedef unsigned short bf16_t;
typedef short bf16x8 __attribute__((ext_vector_type(8)));
typedef float f32x4 __attribute__((ext_vector_type(4)));
typedef unsigned u32x4 __attribute__((ext_vector_type(4)));
constexpr int BM = 256, BK = 64, HALF = 128, HTB = HALF * BK * 2  , STAGE_BYTES = 8 * HTB, NXCD = 8, WGM = 8;

__host__ __device__ __forceinline__ int lds_byte(int r, int c) { const int st = (r >> 4) * 2 + (c >> 5), rr = r & 15, cc = c & 31, ob = rr * 64 + cc * 2; return st * 1024 + (ob ^ (((ob >> 9) & 1) << 5)); }
__host__ __device__ __forceinline__ void stage_rc(int b, int& R, int& C) { const int st = b / 1024, sb = b % 1024, swz = sb ^ (((sb >> 9) & 1) << 5); R = (st >> 1) * 16 + swz / 64; C = (st & 1) * 32 + (swz % 64) / 2; }
__host__ __device__ __forceinline__ int perm32(int rho) { const int n = rho >> 4, i = rho & 15; return 8 * (i >> 2) + 4 * n + (i & 3); }

struct Unit { int pm, pn; };
struct Gemm { const bf16_t* A; const bf16_t* Bt; int M, N, K; };

struct StaticOrder {
    int nM, nN, nwg, G, c;
    __host__ __device__ void init(int M, int N, int G_, int c_) { nM = M / BM; nN = N / BM; nwg = nM * nN; G = G_; c = c_; }
    __host__ __device__ bool next(int i, Unit& u) const {
        const long L = (long)i * G + c; if (L >= nwg) return false;
        int wgid = (int)L; { const int q = nwg / NXCD, r = nwg % NXCD, xcd = wgid % NXCD, off = wgid / NXCD; wgid = (xcd < r ? xcd * (q + 1) : r * (q + 1) + (xcd - r) * q) + off; }
        const int nig = WGM * nN, gid = wgid / nig, fm = gid * WGM, gsz = (nM - fm) < WGM ? (nM - fm) : WGM;
        u.pm = fm + ((wgid % nig) % gsz); u.pn = (wgid % nig) / gsz; return true;
    }
    __device__ __forceinline__ void a_ready(const Unit&) const {}
    __device__ __forceinline__ void done(const Unit&) const {}
};

__device__ __forceinline__ unsigned cvt_pk_bf16(float lo, float hi) { unsigned r; asm volatile("v_cvt_pk_bf16_f32 %0, %1, %2" : "=v"(r) : "v"(lo), "v"(hi)); return r; }
typedef float f32x2 __attribute__((ext_vector_type(2)));
#define EPI_WS(w) size_t z_ = 0; asm volatile("" : "+s"(z_)); unsigned char* w = ws + z_
#define GPTR(T) __attribute__((address_space(1))) T*

__device__ __forceinline__ u32x4 pack8(const f32x4 a, const f32x4 b) { u32x4 w; w.x = cvt_pk_bf16(a[0], a[1]); w.y = cvt_pk_bf16(a[2], a[3]); w.z = cvt_pk_bf16(b[0], b[1]); w.w = cvt_pk_bf16(b[2], b[3]); return w; }

__device__ __forceinline__ void unpack8(const u32x4 v, f32x4& a, f32x4& b) {
    a[0] = __uint_as_float(v.x << 16); a[1] = __uint_as_float(v.x & 0xffff0000u); a[2] = __uint_as_float(v.y << 16); a[3] = __uint_as_float(v.y & 0xffff0000u);
    b[0] = __uint_as_float(v.z << 16); b[1] = __uint_as_float(v.z & 0xffff0000u); b[2] = __uint_as_float(v.w << 16); b[3] = __uint_as_float(v.w & 0xffff0000u); }

struct EpiQKV {
    static constexpr bool PERM = true, AFTER_DRAIN = false;
    unsigned char* ws;
    __device__ __forceinline__ void operator()(const f32x4 (&acc)[2][2][4][2], const Unit& u, int wr, int wc, int fr, int fq) const {
        EPI_WS(w);
        bf16_t* O = (bf16_t*)(w + WS_QKV); const float* rope = (const float*)(w + WS_ROPE);
        const float* bw = (const float*)(w + WS_CS) + BW_IN;
        const int row0 = u.pm * BM + wr * 64 + fr, colb = u.pn * BM + wc * 64 + 8 * fq, gc = u.pn * BM + wc * 32 + 8 * fq;
        const bool do_rope = u.pn < 4;
        const float sc = (u.pn < 2 || u.pn == 6 || u.pn == 7) ? 0.18033688011112042f : 1.f;
        const f32x4 bwa0 = *(const f32x4*)(bw + gc) * sc, bwa1 = *(const f32x4*)(bw + gc + 4) * sc, bwb0 = *(const f32x4*)(bw + gc + HALF) * sc, bwb1 = *(const f32x4*)(bw + gc + HALF + 4) * sc;
#pragma unroll
        for (int ai = 0; ai < 2; ++ai)
#pragma unroll
            for (int m = 0; m < 4; ++m) {
                const int row = row0 + ai * HALF + m * 16;
                f32x4 a0 = acc[ai][0][m][0] * sc + bwa0, a1 = acc[ai][0][m][1] * sc + bwa1;
                f32x4 b0 = acc[ai][1][m][0] * sc + bwb0, b1 = acc[ai][1][m][1] * sc + bwb1;
                if (do_rope) {
                    const f32x4* rp = (const f32x4*)(rope + (size_t)(row & 2047) * 64 + 8 * fq);
                    const f32x4 c0 = rp[0], c1 = rp[1], s0 = rp[8], s1 = rp[9];
                    const f32x4 na0 = a0 * c0 - b0 * s0, nb0 = b0 * c0 + a0 * s0, na1 = a1 * c1 - b1 * s1, nb1 = b1 * c1 + a1 * s1;
                    a0 = na0; a1 = na1; b0 = nb0; b1 = nb1;
                }
                bf16_t* rowp = O + (size_t)row * 3072 + colb;
                *(u32x4*)(rowp) = pack8(a0, a1);
                *(u32x4*)(rowp + 32) = pack8(b0, b1);
                if ((m & (4 - 1)) == 4 - 1) asm volatile("" ::: "memory");
            }
    }
};
template <bool FIRST> __device__ __forceinline__ f32x2 row_stats(const f32x2* st, int row) {
    const f32x2 v = st[row]; if (FIRST) return v;
    const float mu = v.x * (1.f / 1024.f), var = v.y * (1.f / 1024.f) - mu * mu; return (f32x2){mu, __builtin_amdgcn_rsqf(fmaxf(var, 0.f) + 1e-5f)};
}
template <bool FIRST> struct EpiResidLN {
    static constexpr bool PERM = true, AFTER_DRAIN = false;
    unsigned char* ws;
    __device__ __forceinline__ void operator()(const f32x4 (&acc)[2][2][4][2], const Unit& u, int wr, int wc, int fr, int fq) const {
        EPI_WS(w); const float* const* tb = (const float* const*)(w + WS_TBL);
        const GPTR(const float) base = FIRST ? (const GPTR(const float))tb[0] : nullptr; bf16_t* xn = (bf16_t*)(w + WS_XN); const f32x2* st_in = (const f32x2*)(w + (FIRST ? WS_ST0 : WS_ST1));
        const GPTR(const float) g = (const GPTR(const float))tb[FIRST ? 2 : 11]; const GPTR(const float) b = (const GPTR(const float))tb[FIRST ? 3 : 12]; float* st_out = (float*)(w + (FIRST ? WS_ST1 : WS_ST2));
        const int row0 = u.pm * BM + wr * 64 + fr, col0 = u.pn * BM + wc * 32 + 8 * fq;
        f32x4 gv[2][2], bv[2][2];
#pragma unroll
        for (int bj = 0; bj < 2; ++bj)
#pragma unroll
            for (int n = 0; n < 2; ++n) { gv[bj][n] = *(const GPTR(const f32x4))(g + col0 + bj * HALF + 4 * n); bv[bj][n] = *(const GPTR(const f32x4))(b + col0 + bj * HALF + 4 * n); }
#pragma unroll
        for (int ai = 0; ai < 2; ++ai)
#pragma unroll
            for (int m = 0; m < 4; ++m) {
                const int row = row0 + ai * HALF + m * 16; const size_t off = (size_t)row * 1024 + col0;
                const f32x2 ms = row_stats<FIRST>(st_in, row);
                float rs = 0.f, rq = 0.f;
#pragma unroll
                for (int bj = 0; bj < 2; ++bj) { f32x4 y[2], bs[2];
                    if (FIRST) { bs[0] = *(const GPTR(const f32x4))(base + off + bj * HALF); bs[1] = *(const GPTR(const f32x4))(base + off + bj * HALF + 4); }
                    else unpack8(*(const u32x4*)(xn + off + bj * HALF), bs[0], bs[1]);
#pragma unroll
                    for (int n = 0; n < 2; ++n) { const f32x4 h = (bs[n] - ms.x) * ms.y * gv[bj][n] + bv[bj][n];
                        y[n] = h * 1.189207115002721f + acc[ai][bj][m][n];
                        rs += (y[n][0] + y[n][1]) + (y[n][2] + y[n][3]); rq += (y[n][0] * y[n][0] + y[n][1] * y[n][1]) + (y[n][2] * y[n][2] + y[n][3] * y[n][3]); }
                    *(u32x4*)(xn + off + bj * HALF) = pack8(y[0], y[1]); }
                { const int ln = fq * 16 + fr; rs += shx(rs, ln, 16); rs += shx(rs, ln, 32); rq += shx(rq, ln, 16); rq += shx(rq, ln, 32); }
                if (fq < 2) atomicAdd(st_out + 2 * row + fq, fq ? rq : rs);
                if ((m & (4 - 1)) == 4 - 1) asm volatile("" ::: "memory");
            }
    }
};
struct EpiSwiGLU {
    static constexpr bool PERM = true, AFTER_DRAIN = false;
    unsigned char* ws;
    __device__ __forceinline__ void operator()(const f32x4 (&acc)[2][2][4][2], const Unit& u, int wr, int wc, int fr, int fq) const {
        EPI_WS(w);
        bf16_t* O = (bf16_t*)(w + WS_HID); const f32x2* st = (const f32x2*)(w + WS_ST1); const float* cs = (const float*)(w + WS_CS) + CS_GU; const float* bw = (const float*)(w + WS_CS) + BW_GU;
        const int row0 = u.pm * BM + wr * 64 + fr, col0 = u.pn * HALF + wc * 32 + 8 * fq, gc = u.pn * BM + wc * 32 + 8 * fq;
        f32x4 csv[2][2], bwv[2][2];
#pragma unroll
        for (int bj = 0; bj < 2; ++bj)
#pragma unroll
            for (int n = 0; n < 2; ++n) { csv[bj][n] = *(const f32x4*)(cs + gc + bj * HALF + 4 * n); bwv[bj][n] = *(const f32x4*)(bw + gc + bj * HALF + 4 * n); }
#pragma unroll
        for (int ai = 0; ai < 2; ++ai)
#pragma unroll
            for (int m = 0; m < 4; ++m) {
                const int row = row0 + ai * HALF + m * 16;
                const f32x2 ms = row_stats<false>(st, row);
                f32x4 h[2];
#pragma unroll
                for (int n = 0; n < 2; ++n) { const f32x4 g = (acc[ai][0][m][n] - csv[0][n] * ms.x) * ms.y + bwv[0][n], up = (acc[ai][1][m][n] - csv[1][n] * ms.x) * ms.y + bwv[1][n];
#pragma unroll
                    for (int i = 0; i < 4; ++i) { const float e = __builtin_amdgcn_exp2f(-1.4426950408889634f * g[i]); h[n][i] = g[i] * __builtin_amdgcn_rcpf(1.f + e) * up[i]; } }
                *(u32x4*)(O + (size_t)row * 2816 + col0) = pack8(h[0], h[1]);
            }
    }
};
struct EpiPlain {
    static constexpr bool PERM = true, AFTER_DRAIN = false;
    bf16_t* O;
    __device__ __forceinline__ void operator()(const f32x4 (&acc)[2][2][4][2], const Unit& u, int wr, int wc, int fr, int fq) const {
        const int row0 = u.pm * BM + wr * 64 + fr, col0 = u.pn * BM + wc * 32 + 8 * fq;
#pragma unroll
        for (int ai = 0; ai < 2; ++ai)
#pragma unroll
            for (int m = 0; m < 4; ++m)
#pragma unroll
                for (int bj = 0; bj < 2; ++bj) *(u32x4*)(O + (size_t)(row0 + ai * HALF + m * 16) * 1024 + col0 + bj * HALF) = pack8(acc[ai][bj][m][0], acc[ai][bj][m][1]);
    }
};
struct EpiPle {
    static constexpr bool PERM = true, AFTER_DRAIN = false;
    unsigned char* ws;
    __device__ __forceinline__ void operator()(const f32x4 (&acc)[2][2][4][2], const Unit& u, int wr, int wc, int fr, int fq) const {
        EPI_WS(w); const float* const* tb = (const float* const*)(w + WS_TBL);
        const bf16_t* base = (const bf16_t*)(w + WS_XN); bf16_t* out = (bf16_t*)(w + WS_MIX); float* st_out = (float*)(w + WS_ST3); const GPTR(const float) bias = (const GPTR(const float))tb[19]; const bf16_t* E = (const bf16_t*)(w + WS_E);
        const f32x2* st = (const f32x2*)(w + WS_ST2); const float* cs = (const float*)(w + WS_CS) + CS_PG; const float* bw = (const float*)(w + WS_CS) + BW_PG; const GPTR(const float) g = (const GPTR(const float))tb[16]; const GPTR(const float) b = (const GPTR(const float))tb[17];
        const int row0 = u.pm * BM + wr * 64 + fr, col0 = u.pn * BM + wc * 32 + 8 * fq;
        float prs[8], prq[8];
#pragma unroll
        for (int bj = 0; bj < 2; ++bj) {
            const int c = col0 + bj * HALF;
            const f32x4 cs0 = *(const f32x4*)(cs + c), cs1 = *(const f32x4*)(cs + c + 4);
            const f32x4 bb0 = *(const f32x4*)(bw + c) + *(const GPTR(const f32x4))(bias + c), bb1 = *(const f32x4*)(bw + c + 4) + *(const GPTR(const f32x4))(bias + c + 4);
            const f32x4 g0v = *(const GPTR(const f32x4))(g + c), g1v = *(const GPTR(const f32x4))(g + c + 4), b0v = *(const GPTR(const f32x4))(b + c), b1v = *(const GPTR(const f32x4))(b + c + 4);
#pragma unroll
            for (int ai = 0; ai < 2; ++ai)
#pragma unroll
                for (int m = 0; m < 4; ++m) {
                    const int row = row0 + ai * HALF + m * 16; const size_t off = (size_t)row * 1024 + c;
                    const f32x2 ms = row_stats<false>(st, row);
                    const u32x4 ev = *(const u32x4*)(E + off);
                    f32x4 e0, e1; unpack8(ev, e0, e1);
                    const f32x4 z0 = (acc[ai][bj][m][0] - cs0 * ms.x) * ms.y + bb0, z1 = (acc[ai][bj][m][1] - cs1 * ms.x) * ms.y + bb1;
                    f32x4 g0, g1;
#pragma unroll
                    for (int i = 0; i < 4; ++i) { g0[i] = __builtin_amdgcn_rcpf(1.f + __builtin_amdgcn_exp2f(-1.4426950408889634f * z0[i])); g1[i] = __builtin_amdgcn_rcpf(1.f + __builtin_amdgcn_exp2f(-1.4426950408889634f * z1[i])); }
                    f32x4 y0, y1; unpack8(*(const u32x4*)(base + off), y0, y1);
                    const f32x4 h0 = (y0 - ms.x) * ms.y * g0v + b0v, h1 = (y1 - ms.x) * ms.y * g1v + b1v;
                    const f32x4 o0 = h0 * 1.189207115002721f + g0 * e0, o1 = h1 * 1.189207115002721f + g1 * e1;
                    *(u32x4*)(out + off) = pack8(o0, o1);
                    float rs = (o0[0] + o0[1]) + (o0[2] + o0[3]) + (o1[0] + o1[1]) + (o1[2] + o1[3]);
                    float rq = (o0[0] * o0[0] + o0[1] * o0[1]) + (o0[2] * o0[2] + o0[3] * o0[3]) + (o1[0] * o1[0] + o1[1] * o1[1]) + (o1[2] * o1[2] + o1[3] * o1[3]);
                    if (bj == 0) { prs[ai * 4 + m] = rs; prq[ai * 4 + m] = rq; }
                    else { rs += prs[ai * 4 + m]; rq += prq[ai * 4 + m];
                        { const int ln = fq * 16 + fr; rs += shx(rs, ln, 16); rs += shx(rs, ln, 32); rq += shx(rq, ln, 16); rq += shx(rq, ln, 32); }
                        if (fq < 2) atomicAdd(st_out + 2 * row + fq, fq ? rq : rs);     }
                    if ((m & (4 - 1)) == 4 - 1) asm volatile("" ::: "memory");
                }
        }
    }
};

template <class Epi, class Sched, bool ALIGN_EPI = false, bool SP2 = false>
__device__ __forceinline__ void gemm_phase(PG8_LAS unsigned char* lds, const Gemm g, const Sched& S, const Epi& E) {
    int tid_ = threadIdx.x; asm volatile("" : "+v"(tid_));
    const int tid = tid_, wid = __builtin_amdgcn_readfirstlane(tid >> 6), lane = tid & 63, wr = wid >> 2, wc = wid & 3, fr = lane & 15, fq = lane >> 4;
    const int K = g.K, nt = K / BK;
    unsigned voffA[2], voffB[2];
#pragma unroll
    for (int i = 0; i < 2; ++i) { int R, C; stage_rc(tid * 16 + i * 8192, R, C); const int Rb = Epi::PERM ? ((R & ~31) + perm32(R & 31)) : R;
        voffA[i] = (unsigned)(R * K + C) * 2u; voffB[i] = (unsigned)(Rb * K + C) * 2u; }
    const size_t kstep = (size_t)(BK * 2);
    const size_t hstep = (size_t)HALF * K * 2;
    const size_t tstep = 2 * hstep;
    const unsigned ldsw = (unsigned)wid * 1024u;
    const int aoff = lds_byte(wr * 64 + fr, fq * 8), boff = lds_byte(wc * 32 + fr, fq * 8);
#define PG8_SA(b, h) (((b) * 2 + (h)) * HTB)
#define PG8_SB(b, h) ((4 + (b) * 2 + (h)) * HTB)
#define PG8_STAGE(bufoff, gbase, voff) do { _Pragma("unroll") for (int _i = 0; _i < 2; ++_i) \
        __builtin_amdgcn_global_load_lds((const unsigned*)((const char*)(gbase) + (voff)[_i]), (PG8_LAS unsigned*)(lds + (bufoff) + ldsw + _i * 8192), 16, 0, 0); } while (0)
#define PG8_LDA(dst, b, h) do { _Pragma("unroll") for (int m = 0; m < 4; ++m) _Pragma("unroll") for (int k = 0; k < 2; ++k) dst[m][k] = *(const PG8_LAS bf16x8*)(lds + PG8_SA(b, h) + aoff + m * 2048 + k * 1024); } while (0)
#define PG8_LDB(dst, b, h) do { _Pragma("unroll") for (int n = 0; n < 2; ++n) _Pragma("unroll") for (int k = 0; k < 2; ++k) dst[n][k] = *(const PG8_LAS bf16x8*)(lds + PG8_SB(b, h) + boff + n * 2048 + k * 1024); } while (0)
#define PG8_MMA(ai, bj, At, Bt) do { __builtin_amdgcn_s_setprio(1); _Pragma("unroll") for (int m = 0; m < 4; ++m) _Pragma("unroll") for (int n = 0; n < 2; ++n) _Pragma("unroll") for (int k = 0; k < 2; ++k) \
        acc[ai][bj][m][n] = __builtin_amdgcn_mfma_f32_16x16x32_bf16(Bt[n][k], At[m][k], acc[ai][bj][m][n], 0, 0, 0); __builtin_amdgcn_s_setprio(0); } while (0)
#define PG8_WAIT_V(n) asm volatile("s_waitcnt vmcnt(" #n ")" ::: "memory")
#define PG8_WAIT_L(n) asm volatile("s_waitcnt lgkmcnt(" #n ")" ::: "memory")
#define PG8_BAR __builtin_amdgcn_s_barrier()
#define PG8_SCHED __builtin_amdgcn_sched_barrier(0)
    Unit cur, nxt; int ui = 0;
    if (!S.next(0, cur)) return;
    f32x4 acc[2][2][4][2];
#pragma unroll
    for (int a = 0; a < 2; ++a)
#pragma unroll
        for (int b = 0; b < 2; ++b)
#pragma unroll
            for (int m = 0; m < 4; ++m)
#pragma unroll
                for (int n = 0; n < 2; ++n) acc[a][b][m][n] = (f32x4){0.f, 0.f, 0.f, 0.f};
    bf16x8 At[4][2], B0[2][2], B1[2][2];
    const char* cA = (const char*)g.A + (size_t)cur.pm * tstep; const char* cB = (const char*)g.Bt + (size_t)cur.pn * tstep;
    S.a_ready(cur);
    if constexpr (SP2) {
        PG8_STAGE(PG8_SB(0, 0), cB, voffB); PG8_STAGE(PG8_SB(0, 1), cB + hstep, voffB); PG8_STAGE(PG8_SA(0, 0), cA, voffA); PG8_STAGE(PG8_SA(0, 1), cA + hstep, voffA);
        if (wr == 1) PG8_BAR;
        PG8_WAIT_V(2); PG8_BAR;
        PG8_STAGE(PG8_SB(1, 0), cB + kstep, voffB); PG8_STAGE(PG8_SA(1, 0), cA + kstep, voffA); PG8_STAGE(PG8_SB(1, 1), cB + hstep + kstep, voffB);
        PG8_WAIT_V(6); PG8_BAR;
    } else {
        PG8_STAGE(PG8_SB(0, 0), cB, voffB); PG8_STAGE(PG8_SA(0, 0), cA, voffA); PG8_STAGE(PG8_SB(0, 1), cB + hstep, voffB); PG8_STAGE(PG8_SA(0, 1), cA + hstep, voffA);
        if (wr == 1) PG8_BAR;
        PG8_WAIT_V(4); PG8_BAR;
        PG8_STAGE(PG8_SB(1, 0), cB + kstep, voffB); PG8_STAGE(PG8_SA(1, 0), cA + kstep, voffA); PG8_STAGE(PG8_SB(1, 1), cB + hstep + kstep, voffB);
        PG8_WAIT_V(6); PG8_BAR;
    }
    for (;;) {
        const bool has_next = S.next(ui + 1, nxt);
        const char* nA = has_next ? (const char*)g.A + (size_t)nxt.pm * tstep : cA; const char* nB = has_next ? (const char*)g.Bt + (size_t)nxt.pn * tstep : cB;
        for (int t = 0; t < nt; t += 2) {
            const bool last = (t == nt - 2);
            const char* a1 = cA + (size_t)(t + 1) * kstep;
            const char* a2 = last ? nA : cA + (size_t)(t + 2) * kstep; const char* b2 = last ? nB : cB + (size_t)(t + 2) * kstep;
            const char* a3 = a2 + kstep; const char* b3 = b2 + kstep;
            if (last && has_next) S.a_ready(nxt);
            if constexpr (SP2) {
            PG8_LDB(B0, 0, 0); PG8_LDB(B1, 0, 1); PG8_SCHED; PG8_LDA(At, 0, 0); PG8_STAGE(PG8_SA(1, 1), a1 + hstep, voffA);
            PG8_WAIT_V(8); PG8_WAIT_L(0); PG8_BAR; PG8_MMA(0, 0, At, B0); PG8_MMA(0, 1, At, B1); PG8_BAR; PG8_SCHED;
            PG8_LDA(At, 0, 1); PG8_STAGE(PG8_SB(0, 0), b2, voffB); PG8_STAGE(PG8_SB(0, 1), b2 + hstep, voffB); PG8_STAGE(PG8_SA(0, 0), a2, voffA);
            PG8_WAIT_V(8); PG8_WAIT_L(0); PG8_BAR; PG8_MMA(1, 0, At, B0); PG8_MMA(1, 1, At, B1); PG8_BAR; PG8_SCHED;
            PG8_LDB(B0, 1, 0); PG8_LDB(B1, 1, 1); PG8_SCHED; PG8_LDA(At, 1, 0); PG8_STAGE(PG8_SA(0, 1), a2 + hstep, voffA);
            PG8_WAIT_V(8); PG8_WAIT_L(0); PG8_BAR; PG8_MMA(0, 0, At, B0); PG8_MMA(0, 1, At, B1); PG8_BAR; PG8_SCHED;
            PG8_LDA(At, 1, 1); PG8_STAGE(PG8_SB(1, 0), b3, voffB); PG8_STAGE(PG8_SB(1, 1), b3 + hstep, voffB); PG8_STAGE(PG8_SA(1, 0), a3, voffA);
            PG8_WAIT_V(8); PG8_WAIT_L(0); PG8_BAR; PG8_MMA(1, 0, At, B0); PG8_MMA(1, 1, At, B1); PG8_BAR; PG8_SCHED;
            } else {
            PG8_LDB(B0, 0, 0); PG8_SCHED; PG8_LDA(At, 0, 0); PG8_STAGE(PG8_SA(1, 1), a1 + hstep, voffA);
            PG8_WAIT_L(8); PG8_BAR; PG8_WAIT_L(0); PG8_MMA(0, 0, At, B0); PG8_BAR; PG8_SCHED;
            PG8_LDB(B1, 0, 1); PG8_STAGE(PG8_SB(0, 0), b2, voffB);
            PG8_BAR; PG8_WAIT_L(0); PG8_MMA(0, 1, At, B1); PG8_BAR;
            PG8_LDA(At, 0, 1); PG8_STAGE(PG8_SA(0, 0), a2, voffA);
            PG8_BAR; PG8_WAIT_L(0); PG8_MMA(1, 0, At, B0); PG8_BAR; PG8_SCHED;
            PG8_STAGE(PG8_SB(0, 1), b2 + hstep, voffB);
            PG8_WAIT_V(6); PG8_BAR; PG8_MMA(1, 1, At, B1); PG8_BAR;
            PG8_LDB(B0, 1, 0); PG8_SCHED; PG8_LDA(At, 1, 0); PG8_STAGE(PG8_SA(0, 1), a2 + hstep, voffA);
            PG8_WAIT_L(8); PG8_BAR; PG8_WAIT_L(0); PG8_MMA(0, 0, At, B0); PG8_BAR; PG8_SCHED;
            PG8_LDB(B1, 1, 1); PG8_STAGE(PG8_SB(1, 0), b3, voffB);
            PG8_BAR; PG8_WAIT_L(0); PG8_MMA(0, 1, At, B1); PG8_BAR;
            PG8_LDA(At, 1, 1); PG8_STAGE(PG8_SA(1, 0), a3, voffA);
            PG8_BAR; PG8_WAIT_L(0); PG8_MMA(1, 0, At, B0); PG8_BAR; PG8_SCHED;
            PG8_STAGE(PG8_SB(1, 1), b3 + hstep, voffB);
            PG8_WAIT_V(6); PG8_BAR; PG8_MMA(1, 1, At, B1); PG8_BAR;
            }
        }
        if constexpr (ALIGN_EPI) { if (wr == 0) PG8_BAR; }
        if constexpr (!Epi::AFTER_DRAIN) { E(acc, cur, wr, wc, fr, fq); S.done(cur); }
        if (!has_next) break;
#pragma unroll
        for (int a = 0; a < 2; ++a)
#pragma unroll
            for (int b = 0; b < 2; ++b)
#pragma unroll
                for (int m = 0; m < 4; ++m)
#pragma unroll
                    for (int n = 0; n < 2; ++n) acc[a][b][m][n] = (f32x4){0.f, 0.f, 0.f, 0.f};
        cur = nxt; cA = nA; cB = nB; ++ui;
        if constexpr (ALIGN_EPI) { if (wr == 1) PG8_BAR; }
    }
    PG8_WAIT_V(0);
    if constexpr (!ALIGN_EPI) { if (wr == 0) PG8_BAR; }
    PG8_BAR;
    if constexpr (Epi::AFTER_DRAIN) { E.fused(acc, cur, wr, wc, fr, fq, lds, wid, lane); S.done(cur); }
#undef PG8_SA
#undef PG8_SB
#undef PG8_STAGE
#undef PG8_LDA
#undef PG8_LDB
#undef PG8_MMA
#undef PG8_WAIT_V
#undef PG8_WAIT_L
#undef PG8_BAR
#undef PG8_SCHED
}
}

namespace att {
#define LAS __attribute__((address_space(3)))
typedef unsigned short bf16;
using bf16x8 = __attribute__((ext_vector_type(8))) short;
using s16x4 = __attribute__((ext_vector_type(4))) short;
using f32x16 = __attribute__((ext_vector_type(16))) float;
using f32x4 = __attribute__((ext_vector_type(4))) float;
using u32x4 = __attribute__((ext_vector_type(4))) unsigned;
typedef LAS const char* lds_cptr;
typedef LAS char* lds_ptr;
typedef short v4i16_t __attribute__((ext_vector_type(4)));
__device__ __forceinline__ int crow(int r, int hi) { return (r & 3) + 8 * (r >> 2) + 4 * hi; }
__device__ __forceinline__ void glds16(const void* gsrc, unsigned lds_dst) { unsigned keep;
    asm volatile("s_mov_b32 %0, m0\n\ts_mov_b32 m0, %2\n\ts_nop 0\n\tglobal_load_lds_dwordx4 %1, off\n\ts_mov_b32 m0, %0" : "=&s"(keep) : "v"(gsrc), "s"(lds_dst) : "memory"); }
typedef float f32x2_t __attribute__((ext_vector_type(2))); typedef __bf16 bf16x2_t __attribute__((ext_vector_type(2)));
__device__ __forceinline__ unsigned cvtpk(float lo, float hi) { f32x2_t v = {lo, hi}; bf16x2_t b = __builtin_convertvector(v, bf16x2_t); return __builtin_bit_cast(unsigned, b); }
__device__ __forceinline__ s16x4 vtr(lds_cptr p) { return __builtin_bit_cast(s16x4, __builtin_amdgcn_ds_read_tr16_b64_v4i16((LAS v4i16_t*)p)); }
__device__ __forceinline__ float partner32(float x, int hi) { auto rr = __builtin_amdgcn_permlane32_swap(__float_as_uint(x), __float_as_uint(x), false, false); return __uint_as_float(hi ? rr[0] : rr[1]); }

__device__ __forceinline__ void qkt64(f32x16& p0, f32x16& p1, lds_cptr Kslot, const bf16x8* qr, int r32, int hi, const f32x16 init = f32x16{}) {
    lds_cptr kb = Kslot + r32 * 128; const int g = (r32 >> 1) & 7;
    p0 = init; p1 = init;
#pragma unroll
    for (int d0 = 0; d0 < 4; ++d0) {
        const int off = ((2 * d0 + hi) ^ g) << 4;
        const bf16x8 b0 = *(const LAS bf16x8*)(kb + off);
        const bf16x8 b1 = *(const LAS bf16x8*)(kb + off + 4096);
        p0 = __builtin_amdgcn_mfma_f32_32x32x16_bf16(b0, qr[d0], p0, 0, 0, 0);
        p1 = __builtin_amdgcn_mfma_f32_32x32x16_bf16(b1, qr[d0], p1, 0, 0, 0);
    }
}
__device__ __forceinline__ void pv32(f32x16& o, lds_cptr vb, const u32x4 pw0, const u32x4 pw1, const u32x4 pw2, const u32x4 pw3) {
    s16x4 lo[4], hi[4];
#pragma unroll
    for (int ks = 0; ks < 4; ++ks) { lo[ks] = vtr(vb + ks * 1024); hi[ks] = vtr(vb + ks * 1024 + 512); }
#define PKV(k) (bf16x8){lo[k][0], lo[k][1], lo[k][2], lo[k][3], hi[k][0], hi[k][1], hi[k][2], hi[k][3]}
    o = __builtin_amdgcn_mfma_f32_32x32x16_bf16(__builtin_bit_cast(bf16x8, pw0), PKV(0), o, 0, 0, 0);
    o = __builtin_amdgcn_mfma_f32_32x32x16_bf16(__builtin_bit_cast(bf16x8, pw1), PKV(1), o, 0, 0, 0);
    o = __builtin_amdgcn_mfma_f32_32x32x16_bf16(__builtin_bit_cast(bf16x8, pw2), PKV(2), o, 0, 0, 0);
    o = __builtin_amdgcn_mfma_f32_32x32x16_bf16(__builtin_bit_cast(bf16x8, pw3), PKV(3), o, 0, 0, 0);
#undef PKV
}
template <int NB> __device__ __forceinline__ void pvks(f32x16 (&o)[NB], lds_cptr vb, int ks, const u32x4 pw) {
    s16x4 lo[NB], hi[NB];
#pragma unroll
    for (int d = 0; d < NB; ++d) { lo[d] = vtr(vb + d * 4096 + ks * 1024); hi[d] = vtr(vb + d * 4096 + ks * 1024 + 512); }
#pragma unroll
    for (int d = 0; d < NB; ++d) o[d] = __builtin_amdgcn_mfma_f32_32x32x16_bf16(__builtin_bit_cast(bf16x8, pw), (bf16x8){lo[d][0], lo[d][1], lo[d][2], lo[d][3], hi[d][0], hi[d][1], hi[d][2], hi[d][3]}, o[d], 0, 0, 0);
}
#define ATT_WAIT_BAR() asm volatile("s_waitcnt vmcnt(0) lgkmcnt(0)\n\ts_barrier" ::: "memory")

__device__ __forceinline__ float max3f(float a, float b, float c) { float r; asm("v_max3_f32 %0, %1, %2, %3" : "=v"(r) : "v"(a), "v"(b), "v"(c)); return r; }
__device__ __forceinline__ float max2f(float a, float b) { float r; asm("v_max_f32_e32 %0, %1, %2" : "=v"(r) : "v"(a), "v"(b)); return r; }
__device__ __forceinline__ float rowmax32(f32x16& a, f32x16& b, int hi) {
    asm volatile("s_nop 15\n\ts_nop 7" : "+v"(a), "+v"(b));
    float m0 = max3f(a[0], a[1], b[0]), m1 = max3f(a[2], a[3], b[1]); m0 = max3f(m0, b[2], b[3]);
#pragma unroll
    for (int r = 4; r < 16; r += 4) { m0 = max3f(m0, a[r], a[r + 1]); m1 = max3f(m1, a[r + 2], a[r + 3]); m0 = max3f(m0, b[r], b[r + 1]); m1 = max3f(m1, b[r + 2], b[r + 3]); }
    const float mx = max2f(m0, m1);
    return max2f(mx, partner32(mx, hi));
}
constexpr int A_BUF = 32768;
constexpr int A_STAGE = 65536  , A_STAGE_W = 132 * 32 * 4;
constexpr int A_WSF = A_STAGE + 4 * A_STAGE_W;
static_assert(A_WSF + 2048 <= 147456 - 1024, "attention LDS map");

template <bool SKEW> __device__ __forceinline__ void attnA_unit(int b, int h, int blk, const bf16* __restrict__ QKV, bf16* __restrict__ MIX, lds_ptr lds, float lam, const float* __restrict__ subg,
                                                               bool pre, bool has_next, int nb, int nh, int nblk) {
    int tid_ = threadIdx.x; asm volatile("" : "+v"(tid_));
    const int tid = tid_, lane = tid & 63, r32 = lane & 31, hi = lane >> 5; const int wid = __builtin_amdgcn_readfirstlane(tid >> 6);
    const int mp = wid >> 2, wq = wid & 3;
    const long rowbase = (long)b * SEQ; const int q0 = blk * 128;
    const unsigned lds0 = (unsigned)(uintptr_t)lds;
    LAS float* wsf = (LAS float*)(lds + A_WSF) + wid * 64;
    const bf16* Qw = QKV + (rowbase + q0 + wq * 32 + r32) * 3072 + (2 * h + mp) * 64;
    bf16x8 qr[4];
#pragma unroll
    for (int d0 = 0; d0 < 4; ++d0) qr[d0] = *reinterpret_cast<const bf16x8*>(Qw + d0 * 16 + hi * 8);
    const int NT = 2 * blk + 2, my_nt = (wq < 2) ? NT - 1 : NT;
    const bf16* ksrc0 = QKV + (rowbase + 8 * wid + (lane >> 3)) * 3072 + 512 + (2 * h) * 64 + (((lane & 7) ^ (4 * (wid & 1) + (lane >> 4))) << 3);
    const bf16* vsrc0 = QKV + (rowbase + 16 * (wid & 3) + (lane >> 2)) * 3072 + 1024 + h * 128 + (wid >> 2) * 32 + (lane & 3) * 8;
#define A_DMA_FROM(KS, VS, t, buf) do { const long go_ = (long)(t) * 64 * 3072; const unsigned lb_ = lds0 + (unsigned)(buf) * A_BUF + (unsigned)wid * 1024u; \
        glds16((KS) + go_, (unsigned)__builtin_amdgcn_readfirstlane(lb_)); glds16((KS) + go_ + 64, (unsigned)__builtin_amdgcn_readfirstlane(lb_ + 8192u)); \
        glds16((VS) + go_, (unsigned)__builtin_amdgcn_readfirstlane(lb_ + 16384u)); glds16((VS) + go_ + 64, (unsigned)__builtin_amdgcn_readfirstlane(lb_ + 16384u + 8192u)); } while (0)
#define A_DMA(t, buf) A_DMA_FROM(ksrc0, vsrc0, t, buf)
    const int vlane = ((lane >> 4) & 1) * 32 + (lane & 3) * 8 + (4 * hi + ((lane & 15) >> 2)) * 64;
    float mref = 0.f, lrun = 0.f; f32x16 o[4];
#pragma unroll
    for (int d = 0; d < 4; ++d) o[d] = f32x16{};
    if constexpr (SKEW) __builtin_amdgcn_s_setprio(1);
    if (!pre) { A_DMA(0, 0); A_DMA(1, 1); }
    ATT_WAIT_BAR();
    f32x16 sa0, sa1, sb0, sb1; qkt64(sa0, sa1, (lds_cptr)lds + mp * 8192, qr, r32, hi);
    float mx = rowmax32(sa0, sa1, hi);
    int st_prev = 3 * A_BUF, st_cur = 0, st_nxt = A_BUF, st_nn = 2 * A_BUF;
    u32x4 pw0, pw1, pw2, pw3;
#define A_RESC(t) do { \
        if ((t) == 0) mref = mx; \
        else if (__any(mx - mref > 8.f)) { \
            const float dl_ = fmaxf(mx - mref, 0.f), f_ = __builtin_amdgcn_exp2f(-dl_); mref += dl_; lrun *= f_; \
            if (hi == 0) wsf[r32] = f_; \
            asm volatile("s_waitcnt lgkmcnt(0)" ::: "memory"); \
            _Pragma("unroll") for (int rq = 0; rq < 4; ++rq) { const f32x4 fv = *(const LAS f32x4*)(wsf + 8 * rq + 4 * hi); \
                _Pragma("unroll") for (int d = 0; d < 4; ++d) { o[d][4 * rq + 0] *= fv[0]; o[d][4 * rq + 1] *= fv[1]; o[d][4 * rq + 2] *= fv[2]; o[d][4 * rq + 3] *= fv[3]; } } \
        } } while (0)
#define A_WBAR(t) do { if ((t) > 0) ATT_WAIT_BAR(); } while (0)
#define A_ISSUE(t) do { if ((t) + 2 < NT) A_DMA((t) + 2, st_nn / A_BUF); } while (0)
#define A_BAR(t) do { A_WBAR(t); A_ISSUE(t); } while (0)
#define A_ROT() do { const int tmp_ = st_prev; st_prev = st_cur; st_cur = st_nxt; st_nxt = st_nn; st_nn = tmp_; } while (0)
#define A_PW(S, B) (u32x4){cvtpk(S[B], S[B + 1]), cvtpk(S[B + 2], S[B + 3]), cvtpk(S[B + 4], S[B + 5]), cvtpk(S[B + 6], S[B + 7])}
#define A_EXPH(S) _Pragma("unroll") for (int r = 0; r < 16; r += 2) { S[r] = __builtin_amdgcn_exp2f(S[r] - mref); S[r + 1] = __builtin_amdgcn_exp2f(S[r + 1] - mref); ps2[0] += S[r]; ps2[0] += S[r + 1]; }
#define A_STEADY(TT, SA0, SA1, SB0, SB1) do { \
        lds_cptr Vslot = (lds_cptr)lds + st_cur + 16384 + vlane; \
        qkt64(SB0, SB1, (lds_cptr)lds + st_nxt + mp * 8192, qr, r32, hi); \
        A_ISSUE(TT); \
        f32x2_t ps2 = {0.f, 0.f}; A_EXPH(SA0); pw0 = A_PW(SA0, 0); pw1 = A_PW(SA0, 8); \
        __builtin_amdgcn_sched_barrier(0); \
        pvks<4>(o, Vslot, 0, pw0); pvks<4>(o, Vslot, 1, pw1); \
        A_EXPH(SA1); lrun += ps2[0] + ps2[1]; pw2 = A_PW(SA1, 0); pw3 = A_PW(SA1, 8); \
        __builtin_amdgcn_sched_barrier(0); \
        pvks<4>(o, Vslot, 2, pw2); pvks<4>(o, Vslot, 3, pw3); \
        mx = rowmax32(SB0, SB1, hi); } while (0)
#define A_LAST(SA0, SA1) do { \
        lds_cptr Vslot = (lds_cptr)lds + st_cur + 16384 + vlane; \
        f32x2_t ps2 = {0.f, 0.f}; A_EXPH(SA0); pw0 = A_PW(SA0, 0); pw1 = A_PW(SA0, 8); \
        __builtin_amdgcn_sched_barrier(0); \
        pvks<4>(o, Vslot, 0, pw0); pvks<4>(o, Vslot, 1, pw1); \
        A_EXPH(SA1); lrun += ps2[0] + ps2[1]; pw2 = A_PW(SA1, 0); pw3 = A_PW(SA1, 8); \
        __builtin_amdgcn_sched_barrier(0); \
        pvks<4>(o, Vslot, 2, pw2); pvks<4>(o, Vslot, 3, pw3); } while (0)
#define A_PVPREV() do { lds_cptr Vp_ = (lds_cptr)lds + st_prev + 16384 + vlane; __builtin_amdgcn_sched_barrier(0); pvks<4>(o, Vp_, 0, pw0); pvks<4>(o, Vp_, 1, pw1); __builtin_amdgcn_sched_barrier(0); pvks<4>(o, Vp_, 2, pw2); pvks<4>(o, Vp_, 3, pw3); __builtin_amdgcn_sched_barrier(0); } while (0)
#define A_QKEXP(SA0, SA1, SB0, SB1) do { \
        qkt64(SB0, SB1, (lds_cptr)lds + st_nxt + mp * 8192, qr, r32, hi); \
        f32x2_t ps2 = {0.f, 0.f}; A_EXPH(SA0); A_EXPH(SA1); lrun += ps2[0] + ps2[1]; \
        pw0 = A_PW(SA0, 0); pw1 = A_PW(SA0, 8); pw2 = A_PW(SA1, 0); pw3 = A_PW(SA1, 8); \
        mx = rowmax32(SB0, SB1, hi); } while (0)
#define A_EXPONLY(SA0, SA1) do { \
        f32x2_t ps2 = {0.f, 0.f}; A_EXPH(SA0); A_EXPH(SA1); lrun += ps2[0] + ps2[1]; \
        pw0 = A_PW(SA0, 0); pw1 = A_PW(SA0, 8); pw2 = A_PW(SA1, 0); pw3 = A_PW(SA1, 8); } while (0)
#define A_BODY1(t, SA0, SA1, SB0, SB1) do { \
        A_WBAR(t); \
        if ((t) >= 1 && (t) - 1 < my_nt) { A_PVPREV(); } \
        A_ISSUE(t); \
        if ((t) < my_nt) { A_RESC(t); if ((t) + 1 < my_nt) { A_QKEXP(SA0, SA1, SB0, SB1); } else { A_EXPONLY(SA0, SA1); } } \
        A_ROT(); } while (0)
    if constexpr (!SKEW) {
        int t = 0;
        for (; t + 2 < my_nt; t += 2) {
            A_RESC(t); A_WBAR(t); A_STEADY(t, sa0, sa1, sb0, sb1); A_ROT();
            A_RESC(t + 1); A_WBAR(t + 1); A_STEADY(t + 1, sb0, sb1, sa0, sa1); A_ROT();
        }
        if (my_nt - t == 2) { A_RESC(t); A_WBAR(t); A_STEADY(t, sa0, sa1, sb0, sb1); A_ROT(); ++t; A_RESC(t); A_BAR(t); A_LAST(sb0, sb1); A_ROT(); ++t; }
        else { A_RESC(t); A_BAR(t); A_LAST(sa0, sa1); A_ROT(); ++t; }
        for (; t < NT; ++t) { A_BAR(t); A_ROT(); }
    } else {
        for (int t = 0; t < NT; t += 2) { A_BODY1(t, sa0, sa1, sb0, sb1); A_BODY1(t + 1, sb0, sb1, sa0, sa1); }
        if (NT - 1 < my_nt) { A_PVPREV(); }
    }
#undef A_RESC
#undef A_BAR
#undef A_WBAR
#undef A_ISSUE
#undef A_ROT
#undef A_PW
#undef A_EXPH
#undef A_STEADY
#undef A_LAST
#undef A_PVPREV
#undef A_QKEXP
#undef A_EXPONLY
#undef A_BODY1
    if constexpr (SKEW) __builtin_amdgcn_s_setprio(0);
    ATT_WAIT_BAR();
#define A_LDS_BAR() asm volatile("s_waitcnt lgkmcnt(0)\n\ts_barrier" ::: "memory")
    if (has_next) {
        const long nrow = (long)nb * SEQ;
        const bf16* ksn = QKV + (nrow + 8 * wid + (lane >> 3)) * 3072 + 512 + (2 * nh) * 64 + (((lane & 7) ^ (4 * (wid & 1) + (lane >> 4))) << 3);
        const bf16* vsn = QKV + (nrow + 16 * (wid & 3) + (lane >> 2)) * 3072 + 1024 + nh * 128 + (wid >> 2) * 32 + (lane & 3) * 8;
        A_DMA_FROM(ksn, vsn, 0, 0); A_DMA_FROM(ksn, vsn, 1, 1);
    }
#undef A_DMA
#undef A_DMA_FROM
    { const float lt = lrun + partner32(lrun, hi); if (hi == 0) wsf[32 + r32] = 1.f / lt; }
    asm volatile("s_waitcnt lgkmcnt(0)" ::: "memory");
#pragma unroll
    for (int rq = 0; rq < 4; ++rq) { const f32x4 fv = *(const LAS f32x4*)(wsf + 32 + 8 * rq + 4 * hi);
#pragma unroll
        for (int d = 0; d < 4; ++d) { o[d][4 * rq + 0] *= fv[0]; o[d][4 * rq + 1] *= fv[1]; o[d][4 * rq + 2] *= fv[2]; o[d][4 * rq + 3] *= fv[3]; } }
    LAS f32x4* xb = (LAS f32x4*)(lds + A_STAGE);
    if (mp == 1) {
#pragma unroll
        for (int d = 0; d < 4; ++d)
#pragma unroll
            for (int rq = 0; rq < 4; ++rq) xb[((d * 4 + rq) * 4 + wq) * 64 + lane] = (f32x4){o[d][4 * rq], o[d][4 * rq + 1], o[d][4 * rq + 2], o[d][4 * rq + 3]};
    }
    A_LDS_BAR();
    if (mp == 0) {
#pragma unroll
        for (int d = 0; d < 4; ++d)
#pragma unroll
            for (int rq = 0; rq < 4; ++rq) { const f32x4 x2 = xb[((d * 4 + rq) * 4 + wq) * 64 + lane];
#pragma unroll
                for (int i = 0; i < 4; ++i) o[d][4 * rq + i] -= lam * x2[i]; }
    }
    A_LDS_BAR();
    if (mp == 0) {
        LAS float* stg = (LAS float*)(lds + A_STAGE + wq * A_STAGE_W);
#pragma unroll
        for (int d = 0; d < 4; ++d)
#pragma unroll
            for (int r = 0; r < 16; ++r) stg[crow(r, hi) * 132 + d * 32 + r32] = o[d][r];
        asm volatile("s_waitcnt lgkmcnt(0)" ::: "memory");
        const int row = lane >> 1, half = lane & 1;
        f32x4 v[16]; float ss = 0.f;
#pragma unroll
        for (int i = 0; i < 16; ++i) { v[i] = *(const LAS f32x4*)(stg + row * 132 + half * 64 + 4 * i); ss += (v[i][0] * v[i][0] + v[i][1] * v[i][1]) + (v[i][2] * v[i][2] + v[i][3] * v[i][3]); }
        ss += shx(ss, lane, 1);
        const float rs = (1.f - LAMBDA_INIT) / sqrtf(ss * (1.f / 128.f) + LN_EPS);
        bf16* orow = MIX + (rowbase + q0 + wq * 32 + row) * 1024 + h * 128 + half * 64;
        const f32x4* gp = (const f32x4*)(subg + half * 64);
#pragma unroll
        for (int i = 0; i < 8; ++i) { const f32x4 g0 = gp[2 * i], g1 = gp[2 * i + 1]; const f32x4 a = v[2 * i] * g0 * rs, c = v[2 * i + 1] * g1 * rs;
            u32x4 w; w.x = cvtpk(a[0], a[1]); w.y = cvtpk(a[2], a[3]); w.z = cvtpk(c[0], c[1]); w.w = cvtpk(c[2], c[3]); *(u32x4*)(orow + 8 * i) = w; }
        asm volatile("s_waitcnt lgkmcnt(0)" ::: "memory");
    }
#undef A_LDS_BAR
}

__device__ __forceinline__ void attnB_wave(int gw, int NGW, int NU, const bf16* __restrict__ QKV, bf16* __restrict__ MIX, lds_ptr wl  ) {
    int tid_ = threadIdx.x; asm volatile("" : "+v"(tid_));
    const int lane = tid_ & 63, r32 = lane & 31, hi = lane >> 5;
    const unsigned wl0 = (unsigned)__builtin_amdgcn_readfirstlane((unsigned)(uintptr_t)wl);
    const int kce = ((lane & 7) ^ (lane >> 4)) << 3, kco = ((lane & 7) ^ (4 + (lane >> 4))) << 3;
    int u = gw; if (u >= NU) return;
    long rowbase; int q0, hh, jd; const bf16* ksrc; const bf16* vsrc; bf16x8 qr[4], qn[4];
#define B_SETUP(uu, QF) do { const int bh_ = (uu) >> 6; hh = bh_ & 7; rowbase = (long)(bh_ >> 3) * SEQ; jd = ((uu) + 8 * (bh_ >> 5)) & 63  ; q0 = jd * 32; \
        const bf16* Qw_ = QKV + (rowbase + q0 + r32) * 3072 + 1536 + hh * 64; \
        _Pragma("unroll") for (int d0 = 0; d0 < 4; ++d0) QF[d0] = *reinterpret_cast<const bf16x8*>(Qw_ + d0 * 16 + hi * 8); \
        ksrc = QKV + (rowbase + (lane >> 3)) * 3072 + 2048 + hh * 64; vsrc = QKV + (rowbase + (lane >> 2)) * 3072 + 2560 + hh * 64 + (lane & 3) * 8; } while (0)
    const int vlane = ((lane >> 4) & 1) * 32 + (lane & 3) * 8 + (4 * hi + ((lane & 15) >> 2)) * 64;
    const int kgl = (r32 >> 1) & 7;
#define B_DMA(j, bo) do { const long go_ = (long)(j) * 32 * 3072; \
        _Pragma("unroll") for (int c_ = 0; c_ < 4; ++c_) glds16(ksrc + go_ + (long)(8 * c_) * 3072 + ((c_ & 1) ? kco : kce), wl0 + (bo) + c_ * 1024); \
        _Pragma("unroll") for (int p_ = 0; p_ < 4; ++p_) glds16(vsrc + go_ + (long)(16 * (p_ & 1)) * 3072 + (p_ >> 1) * 32, wl0 + (bo) + 4096 + p_ * 1024); } while (0)
    B_SETUP(u, qr); B_DMA(jd, 8192);
    for (;;) {
    f32x16 o[2]; o[0] = f32x16{}; o[1] = f32x16{};
    float C = 1.f, R = 0.f;
    int bo = 8192;
    for (int j = jd; j >= 0; --j) {
        if (j > 0) { asm volatile("s_waitcnt lgkmcnt(0)" ::: "memory"); B_DMA(j - 1, bo ^ 8192); asm volatile("s_waitcnt vmcnt(8)" ::: "memory"); }
        else asm volatile("s_waitcnt vmcnt(0)" ::: "memory");
        lds_cptr Kb = (lds_cptr)wl + bo + r32 * 128;
        f32x16 p = f32x16{};
#pragma unroll
        for (int d0 = 0; d0 < 4; ++d0) p = __builtin_amdgcn_mfma_f32_32x32x16_bf16(*(const LAS bf16x8*)(Kb + (((2 * d0 + hi) ^ kgl) << 4)), qr[d0], p, 0, 0, 0);
        const int qloc = q0 + r32 - 32 * j;
        float beta[16], omb[16];
#pragma unroll
        for (int r = 0; r < 16; ++r) {
            const float zz = __builtin_amdgcn_fmed3f(p[r], -126.f, 3.0e38f), e = __builtin_amdgcn_exp2f(-zz), r0 = __builtin_amdgcn_rcpf(1.f + e);
            beta[r] = r0; omb[r] = e * r0;
        }
        if (j == jd) {
#pragma unroll
            for (int r = 0; r < 16; ++r) { const bool valid = crow(r, hi) < qloc; beta[r] = valid ? beta[r] : 0.f; omb[r] = valid ? omb[r] : 1.f; }
        }
        float insuf[16], gp[4], pg[4];
#pragma unroll
        for (int g = 0; g < 4; ++g) { insuf[4 * g + 3] = 1.f; insuf[4 * g + 2] = omb[4 * g + 3]; insuf[4 * g + 1] = insuf[4 * g + 2] * omb[4 * g + 2]; insuf[4 * g] = insuf[4 * g + 1] * omb[4 * g + 1]; gp[g] = insuf[4 * g] * omb[4 * g]; }
#pragma unroll
        for (int g = 0; g < 4; ++g) pg[g] = partner32(gp[g], hi);
        float acc = C, S[4];
#pragma unroll
        for (int g = 3; g >= 0; --g) { S[g] = hi ? acc : acc * pg[g]; acc *= gp[g] * pg[g]; }
        C = acc; R = __builtin_amdgcn_logf(acc);
#pragma unroll
        for (int r = 0; r < 16; ++r) p[r] = beta[r] * (insuf[r] * S[r >> 2]);
        const u32x4 pw0 = {cvtpk(p[0], p[1]), cvtpk(p[2], p[3]), cvtpk(p[4], p[5]), cvtpk(p[6], p[7])}, pw1 = {cvtpk(p[8], p[9]), cvtpk(p[10], p[11]), cvtpk(p[12], p[13]), cvtpk(p[14], p[15])};
        lds_cptr vb = (lds_cptr)wl + bo + 4096 + vlane;
#pragma unroll
        for (int d = 0; d < 2; ++d) {
            const s16x4 l0 = vtr(vb + d * 2048), h0 = vtr(vb + d * 2048 + 512), l1 = vtr(vb + d * 2048 + 1024), h1 = vtr(vb + d * 2048 + 1536);
            o[d] = __builtin_amdgcn_mfma_f32_32x32x16_bf16(__builtin_bit_cast(bf16x8, pw0), (bf16x8){l0[0], l0[1], l0[2], l0[3], h0[0], h0[1], h0[2], h0[3]}, o[d], 0, 0, 0);
            o[d] = __builtin_amdgcn_mfma_f32_32x32x16_bf16(__builtin_bit_cast(bf16x8, pw1), (bf16x8){l1[0], l1[1], l1[2], l1[3], h1[0], h1[1], h1[2], h1[3]}, o[d], 0, 0, 0);
        }
        bo ^= 8192;
        if (!__any(R > -150.f)) break;
    }
    asm volatile("s_waitcnt vmcnt(0) lgkmcnt(0)" ::: "memory");
    const long orow0 = rowbase + q0; const int oh = hh;
    const int un = u + NGW;
    if (un < NU) { B_SETUP(un, qn); B_DMA(jd, 8192); }
    LAS bf16* stg = (LAS bf16*)wl;
#pragma unroll
    for (int r = 0; r < 16; ++r) { const int orow = crow(r, hi);
#pragma unroll
        for (int d0 = 0; d0 < 2; ++d0) stg[orow * 64 + d0 * 32 + r32] = (bf16)(cvtpk(o[d0][r], 0.f) & 0xffffu); }
    asm volatile("s_waitcnt lgkmcnt(0)" ::: "memory");
    bf16* Ow = MIX + orow0 * 1024 + 512 + oh * 64;
#pragma unroll
    for (int i = 0; i < 4; ++i) { const int row = i * 8 + (lane >> 3), ch = lane & 7; const u32x4 v = *(const LAS u32x4*)(stg + row * 64 + ch * 8); *(u32x4*)(Ow + (long)row * 1024 + ch * 8) = v; }
    asm volatile("s_waitcnt lgkmcnt(0)" ::: "memory");
    if (un >= NU) break;
    u = un;
#pragma unroll
    for (int d0 = 0; d0 < 4; ++d0) qr[d0] = qn[d0];
    }
#undef B_DMA
#undef B_SETUP
}
#undef LAS
}

constexpr int LDS_BYTES = 147456;
constexpr int NWAVES = 8;

#define GAS __attribute__((address_space(1)))
#define LAS __attribute__((address_space(3)))
typedef unsigned short bf16;
typedef unsigned v4u __attribute__((ext_vector_type(4)));
typedef float f32x4 __attribute__((ext_vector_type(4)));
#define LDS_WAIT() asm volatile("s_waitcnt lgkmcnt(0)" ::: "memory")
__device__ __forceinline__ unsigned f2bf(float f) { unsigned u = __builtin_bit_cast(unsigned, f); return (u + 0x7fffu + ((u >> 16) & 1u)) >> 16; }
__device__ __forceinline__ unsigned pk2(float lo, float hi) { return f2bf(lo) | (f2bf(hi) << 16); }
__device__ __forceinline__ float wave_sum(float v, int lane) {
#pragma unroll
    for (int o = 1; o < 64; o <<= 1) v += shx(v, lane, o);
    return v;
}
#define XB_TMO      128
#define XB_XCNT(j)  (256  + 64 * (j))
#define XB_XSUB(j)  (1280 + 64 * (j))
#define XB_XGEN(j)  (2304 + 64 * (j))
#define XB_TOP      3328
#define XB_TOPGEN   3392
#define XCD_BAR_WORDS 3456
#define XB_SPIN_CAP (1u << 18)

__device__ __forceinline__ unsigned xb_ld(unsigned* p)              { return __hip_atomic_load(p, __ATOMIC_RELAXED, __HIP_MEMORY_SCOPE_AGENT); }
__device__ __forceinline__ unsigned xb_add(unsigned* p, unsigned v) { return __hip_atomic_fetch_add(p, v, __ATOMIC_RELAXED, __HIP_MEMORY_SCOPE_AGENT); }
__device__ __forceinline__ unsigned xb_xcc_id() { return (unsigned)__builtin_amdgcn_s_getreg((3 << 11) | 20) & 0xFu; }
#define XB_SPIN(cond, bar) do { unsigned _sp = 0; while (cond) { __builtin_amdgcn_s_sleep(1); \
    if ((++_sp & 255u) == 0u) { if (xb_ld(&(bar)[XB_TMO])) break; if (_sp > XB_SPIN_CAP) { atomicAdd(&(bar)[XB_TMO], 1u); break; } } } } while (0)

struct XcdBarrier {
    unsigned* bar; unsigned x;
    volatile LAS unsigned* st;
};

__device__ __forceinline__ XcdBarrier xcd_barrier_post(unsigned* bar, volatile LAS unsigned* st) {
    XcdBarrier b; b.bar = bar; b.x = xb_xcc_id(); b.st = st;
    if (threadIdx.x == 0) (void)xb_add(&bar[XB_XCNT(b.x)], 1u);
    return b;
}
__device__ __forceinline__ void xcd_barrier_complete(unsigned* bar, unsigned x, unsigned& nloc, unsigned& nx) {
    const unsigned G = gridDim.x * gridDim.y * gridDim.z;
    unsigned sum, cnt, mine, sp = 0u;
    for (;;) {
        sum = 0u; cnt = 0u; mine = 0u;
#pragma unroll
        for (unsigned j = 0; j < 16; ++j) { const unsigned c = xb_ld(&bar[XB_XCNT(j)]); sum += c; cnt += (c > 0u) ? 1u : 0u; mine = (j == x) ? c : mine; }
        if (sum == G) break;
        __builtin_amdgcn_s_sleep(1);
        if ((++sp & 255u) == 0u) { if (xb_ld(&bar[XB_TMO])) break; if (sp > XB_SPIN_CAP) { atomicAdd(&bar[XB_TMO], 1u); break; } }
    }
    nloc = mine > 0u ? mine : 1u; nx = cnt > 0u ? cnt : 1u;
}

__device__ __forceinline__ void xcd_barrier(const XcdBarrier& b) {
    asm volatile("s_waitcnt vmcnt(0)" ::: "memory");
    __syncthreads();
    if (threadIdx.x == 0) {
        unsigned* bar = b.bar;
        __builtin_amdgcn_s_waitcnt(0);
        unsigned nloc = b.st[0], nx = b.st[1];
        if (nloc == 0u) { xcd_barrier_complete(bar, b.x, nloc, nx); b.st[0] = nloc; b.st[1] = nx; }
        const unsigned old = xb_add(&bar[XB_XSUB(b.x)], 1u);
        const unsigned gen = old / nloc;
        if (old + 1u == (gen + 1u) * nloc) {
            __builtin_amdgcn_fence(__ATOMIC_RELEASE, "agent");
            asm volatile("s_waitcnt vmcnt(0)" ::: "memory");
            const unsigned og = xb_add(&bar[XB_TOP], 1u);
            const unsigned tg = og / nx;
            if (og + 1u == (tg + 1u) * nx) xb_add(&bar[XB_TOPGEN], 1u);
            else XB_SPIN(xb_ld(&bar[XB_TOPGEN]) == tg, bar);
            __builtin_amdgcn_fence(__ATOMIC_ACQUIRE, "agent");
            xb_add(&bar[XB_XGEN(b.x)], 1u);
            asm volatile("s_waitcnt vmcnt(0)" ::: "memory");
        } else {
            XB_SPIN(xb_ld(&bar[XB_XGEN(b.x)]) == gen, bar);
            __builtin_amdgcn_fence(__ATOMIC_ACQUIRE, "agent");
            asm volatile("s_waitcnt vmcnt(0)" ::: "memory");
        }
    }
    __syncthreads();
}

__device__ __forceinline__ void transpose_item(const float* W, int K, int N, bf16* WT, int k0, int n0, int drow, LAS float* scr, int lane, const float* gk = nullptr) {
#pragma unroll 8
    for (int i = 0; i < 32; ++i) { const int kk = 2 * i + (lane >> 5); scr[kk * 33 + (lane & 31)] = W[(size_t)(k0 + kk) * N + n0 + (lane & 31)] * (gk ? gk[k0 + kk] : 1.f); }
    LDS_WAIT(); asm volatile("" ::: "memory");
    const int c = lane & 7;
#pragma unroll
    for (int j = 0; j < 4; ++j) { const int n = (lane >> 3) + 8 * j; const LAS float* s = scr + (8 * c) * 33 + n;
        v4u o; o.x = pk2(s[0 * 33], s[1 * 33]); o.y = pk2(s[2 * 33], s[3 * 33]); o.z = pk2(s[4 * 33], s[5 * 33]); o.w = pk2(s[6 * 33], s[7 * 33]);
        *(v4u*)(WT + (size_t)(drow + n) * K + k0 + 8 * c) = o; }
    LDS_WAIT(); asm volatile("" ::: "memory");
}
template <bool WF32, bool WBF16> __device__ __forceinline__ void ln_row(f32x4 (&v)[4], float* orow, bf16* brow, const f32x4 (&g)[4], const f32x4 (&bb)[4], int lane) {
    float s = 0.f;
#pragma unroll
    for (int j = 0; j < 4; ++j) s += (v[j].x + v[j].y) + (v[j].z + v[j].w);
    const float mean = wave_sum(s, lane) * (1.f / DM); float s2 = 0.f;
#pragma unroll
    for (int j = 0; j < 4; ++j) { v[j] = v[j] - mean; s2 += (v[j].x * v[j].x + v[j].y * v[j].y) + (v[j].z * v[j].z + v[j].w * v[j].w); }
    const float rstd = 1.f / sqrtf(wave_sum(s2, lane) * (1.f / DM) + LN_EPS);
#pragma unroll
    for (int j = 0; j < 4; ++j) { const f32x4 y = v[j] * rstd * g[j] + bb[j];
        if (WF32) ((f32x4*)orow + lane)[64 * j] = y;
        if (WBF16) ((unsigned long long*)brow + lane)[64 * j] = (unsigned long long)pk2(y.x, y.y) | ((unsigned long long)pk2(y.z, y.w) << 32); }
}
template <bool WF32, bool WBF16> __device__ __forceinline__ void ln_rows(const float* in, float* out, bf16* xn, const float* g, const float* b, int gw, int NGW, int lane) {
    f32x4 gv[4], bv[4];
#pragma unroll
    for (int j = 0; j < 4; ++j) { gv[j] = ((const f32x4*)g + lane)[64 * j]; bv[j] = ((const f32x4*)b + lane)[64 * j]; }
    f32x4 cur[4], nxt[4];
    if (gw < MTOK) {
#pragma unroll
        for (int j = 0; j < 4; ++j) cur[j] = ((const f32x4*)(in + (size_t)gw * DM) + lane)[64 * j]; }
    for (int m = gw; m < MTOK; m += NGW) {
        const int mn = m + NGW;
        if (mn < MTOK) {
#pragma unroll
            for (int j = 0; j < 4; ++j) nxt[j] = ((const f32x4*)(in + (size_t)mn * DM) + lane)[64 * j]; }
        ln_row<WF32, WBF16>(cur, out + (size_t)m * DM, xn + (size_t)m * DM, gv, bv, lane);
#pragma unroll
        for (int j = 0; j < 4; ++j) cur[j] = nxt[j];
    }
}

struct Args { const float* in[23]; float* out; unsigned char* ws; };
__global__ void __launch_bounds__(NWAVES * 64, 2) fwd_kernel(Args args) {
    extern __shared__ __attribute__((aligned(16))) unsigned char lds_raw[];
    cg::grid_group grid = cg::this_grid();
    LAS unsigned char* lds = (LAS unsigned char*)lds_raw;
    const int wave = __builtin_amdgcn_readfirstlane(threadIdx.x >> 6);
#define OPAQUE_TID(name) int name = threadIdx.x; asm volatile("" : "+v"(name))
    const int G = gridDim.x, bx = blockIdx.x, vcu = (G % 8 == 0) ? (bx % 8) * (G / 8) + bx / 8 : bx;
    const int gw = vcu * NWAVES + wave, NGW = G * NWAVES;
    unsigned char* ws = args.ws;
    volatile LAS unsigned* xst = (volatile LAS unsigned*)(lds + LDS_BYTES - 64);
    if (threadIdx.x < 2) xst[threadIdx.x] = 0u;
    __syncthreads();
    const XcdBarrier xbar = xcd_barrier_post((unsigned*)(ws + WS_BAR), xst);
    const float* x = args.in[0]; const float* p = args.in[1];
    float* out = args.out;
    bf16* W_in = (bf16*)(ws + WS_WIN); bf16* W_out = (bf16*)(ws + WS_WOUT); bf16* W_gu = (bf16*)(ws + WS_WGU); bf16* W_dn = (bf16*)(ws + WS_WDN); bf16* W_pg = (bf16*)(ws + WS_WPG); bf16* W_pp = (bf16*)(ws + WS_WPP);
    float* rope = (float*)(ws + WS_ROPE); float* csbw = (float*)(ws + WS_CS);
    pg8::f32x2* st0 = (pg8::f32x2*)(ws + WS_ST0); pg8::f32x2* st1 = (pg8::f32x2*)(ws + WS_ST1); pg8::f32x2* st2 = (pg8::f32x2*)(ws + WS_ST2); pg8::f32x2* st3 = (pg8::f32x2*)(ws + WS_ST3);
    bf16* XN = (bf16*)(ws + WS_XN); bf16* QKV = (bf16*)(ws + WS_QKV); bf16* HID = (bf16*)(ws + WS_HID); bf16* MIX = (bf16*)(ws + WS_MIX); bf16* PB = (bf16*)(ws + WS_PB); bf16* EB = (bf16*)(ws + WS_E);

#ifndef NO_P0
    {
        OPAQUE_TID(tid); const int lane = tid & 63;
        if (bx == 0 && tid < 23) ((const float**)(ws + WS_TBL))[tid] = args.in[tid];
        LAS float* scr = (LAS float*)(lds + wave * 16384);
        constexpr int I_IN = 16 * 96, I_OUT = 16 * 32, I_G = 16 * 88, I_U = 16 * 88, I_DN = 44 * 32, I_PG = 16 * 32, I_PP = 4 * 32;
        constexpr int NITEMS = I_IN + I_OUT + I_G + I_U + I_DN + I_PG + I_PP;
        for (int it = gw; it < NITEMS; it += NGW) {
            int r = it;
            if (r < I_IN) { const int kb = r / 96, nb = r % 96, n0 = 32 * nb; const int drow = (n0 & ~255) + 128 * ((n0 >> 5) & 1) + 32 * ((n0 >> 6) & 3);
                transpose_item(args.in[4], 1024, 3072, W_in, 64 * kb, n0, drow, scr, lane, args.in[2]); continue; } r -= I_IN;
            if (r < I_OUT) { const int kb = r / 32, nb = r % 32; transpose_item(args.in[10], 1024, 1024, W_out, 64 * kb, 32 * nb, 32 * nb, scr, lane); continue; } r -= I_OUT;
            if (r < I_G) { const int kb = r / 88, nb = r % 88, n0 = 32 * nb; transpose_item(args.in[13], 1024, 2816, W_gu, 64 * kb, n0, 256 * (n0 >> 7) + (n0 & 127), scr, lane, args.in[11]); continue; } r -= I_G;
            if (r < I_U) { const int kb = r / 88, nb = r % 88, n0 = 32 * nb; transpose_item(args.in[14], 1024, 2816, W_gu, 64 * kb, n0, 256 * (n0 >> 7) + 128 + (n0 & 127), scr, lane, args.in[11]); continue; } r -= I_U;
            if (r < I_DN) { const int kb = r / 32, nb = r % 32; transpose_item(args.in[15], 2816, 1024, W_dn, 64 * kb, 32 * nb, 32 * nb, scr, lane); continue; } r -= I_DN;
            if (r < I_PG) { const int kb = r / 32, nb = r % 32; transpose_item(args.in[18], 1024, 1024, W_pg, 64 * kb, 32 * nb, 32 * nb, scr, lane, args.in[16]); continue; } r -= I_PG;
            { const int kb = r / 32, nb = r % 32; transpose_item(args.in[20], 256, 1024, W_pp, 64 * kb, 32 * nb, 32 * nb, scr, lane); }
        }
        for (int e = bx * (NWAVES * 64) + tid; e < SEQ * 32; e += G * NWAVES * 64) {
            const int pos = e >> 5, j = e & 31;
            double inv = 1.0; for (int k = 0; k < j; ++k) inv *= 0.74989420933245582730;
            const double a = (double)pos * (double)(float)inv, rev = a * 0.15915494309189533577; const float fr = (float)(rev - floor(rev));
            rope[pos * 64 + j] = __builtin_amdgcn_cosf(fr); rope[pos * 64 + 32 + j] = __builtin_amdgcn_sinf(fr);
        }
        for (int m = gw; m < MTOK; m += 4 * NGW) {
            f32x4 v[4];
#pragma unroll
            for (int q = 0; q < 4; ++q) if (m + q * NGW < MTOK) v[q] = ((const f32x4*)(p + (size_t)(m + q * NGW) * PLE))[lane];
#pragma unroll
            for (int q = 0; q < 4; ++q) if (m + q * NGW < MTOK) ((unsigned long long*)(PB + (size_t)(m + q * NGW) * PLE))[lane] = (unsigned long long)pk2(v[q].x, v[q].y) | ((unsigned long long)pk2(v[q].z, v[q].w) << 32);
        }
        for (int it = (gw + NGW - (NITEMS % NGW)) % NGW; it < 152 * 8; it += NGW) {
            const int cb = it >> 3, kc = (it & 7) * 128;
            const float* W; const float* gk; const float* bk; int N, n, idx, co, bo;
            if (cb < 48) { W = args.in[4]; N = 3072; n = 64 * cb + lane; gk = args.in[2]; bk = args.in[3]; idx = (n & ~255) + 128 * ((n >> 5) & 1) + 32 * ((n >> 6) & 3) + (n & 31); co = CS_IN; bo = BW_IN; }
            else if (cb < 92) { W = args.in[13]; N = 2816; n = 64 * (cb - 48) + lane; gk = args.in[11]; bk = args.in[12]; idx = 256 * (n >> 7) + (n & 127); co = CS_GU; bo = BW_GU; }
            else if (cb < 136) { W = args.in[14]; N = 2816; n = 64 * (cb - 92) + lane; gk = args.in[11]; bk = args.in[12]; idx = 256 * (n >> 7) + 128 + (n & 127); co = CS_GU; bo = BW_GU; }
            else { W = args.in[18]; N = 1024; n = 64 * (cb - 136) + lane; gk = args.in[16]; bk = args.in[17]; idx = n; co = CS_PG; bo = BW_PG; }
            float a0 = 0.f, a1 = 0.f, c0 = 0.f, c1 = 0.f;
#pragma unroll 8
            for (int k = kc; k < kc + 128; k += 2) { const float w0 = W[(size_t)k * N + n], w1 = W[(size_t)(k + 1) * N + n];
                a0 += __uint_as_float(f2bf(gk[k] * w0) << 16); a1 += __uint_as_float(f2bf(gk[k + 1] * w1) << 16); c0 += bk[k] * w0; c1 += bk[k + 1] * w1; }
            atomicAdd(csbw + co + idx, a0 + a1); atomicAdd(csbw + bo + idx, c0 + c1);
        }
        f32x4 v[4], nx[4];
        if (gw < MTOK) {
#pragma unroll
            for (int j = 0; j < 4; ++j) v[j] = ((const f32x4*)(x + (size_t)gw * DM) + lane)[64 * j]; }
        for (int m = gw; m < MTOK; m += NGW) {
            const int mn = m + NGW;
            if (mn < MTOK) {
#pragma unroll
                for (int j = 0; j < 4; ++j) nx[j] = ((const f32x4*)(x + (size_t)mn * DM) + lane)[64 * j]; }
            float s1 = 0.f;
#pragma unroll
            for (int j = 0; j < 4; ++j) s1 += (v[j].x + v[j].y) + (v[j].z + v[j].w);
            const float mean = wave_sum(s1, lane) * (1.f / DM); float s2 = 0.f;
#pragma unroll
            for (int j = 0; j < 4; ++j) { const f32x4 d = v[j] - mean; s2 += (d.x * d.x + d.y * d.y) + (d.z * d.z + d.w * d.w); }
            const float rstd = 1.f / sqrtf(wave_sum(s2, lane) * (1.f / DM) + LN_EPS);
#pragma unroll
            for (int j = 0; j < 4; ++j) { const f32x4 y = (v[j] - mean) * rstd; ((unsigned long long*)(XN + (size_t)m * DM) + lane)[64 * j] = (unsigned long long)pk2(y.x, y.y) | ((unsigned long long)pk2(y.z, y.w) << 32); }
#pragma unroll
            for (int j = 0; j < 4; ++j) v[j] = nx[j];
            if (lane == 0) st0[m] = (pg8::f32x2){mean, rstd};
            if (lane == 1) st1[m] = (pg8::f32x2){0.f, 0.f};
            if (lane == 2) st2[m] = (pg8::f32x2){0.f, 0.f};
            if (lane == 3) st3[m] = (pg8::f32x2){0.f, 0.f};
        }
    }
#endif
    if (args.ws == nullptr) grid.sync();
    xcd_barrier(xbar);
#ifndef NO_P1
    {
        { pg8::Gemm g{XN, W_in, MTOK, NIN, DM}; pg8::StaticOrder S; S.init(MTOK, NIN, G, bx); pg8::EpiQKV E{ws};
          pg8::gemm_phase<pg8::EpiQKV, pg8::StaticOrder, true, true>(lds, g, S, E); }
        __syncthreads();
        { int kpp = PLE; asm volatile("" : "+s"(kpp));
          pg8::Gemm g{PB, W_pp, MTOK, DM, kpp}; pg8::StaticOrder S; S.init(MTOK, DM, G, bx); pg8::EpiPlain E{EB};
          pg8::gemm_phase<pg8::EpiPlain, pg8::StaticOrder, true, true>(lds, g, S, E); }
    }
#endif
    xcd_barrier(xbar);
#ifndef NO_P2
    {
        float lam;
        { OPAQUE_TID(tid); const int lane = tid & 63; const float a = args.in[5][lane] * args.in[6][lane], c = args.in[7][lane] * args.in[8][lane];
          lam = __uint_as_float(__builtin_amdgcn_readfirstlane(__float_as_uint(expf(wave_sum(a, lane)) - expf(wave_sum(c, lane)) + LAMBDA_INIT))); }
        { bool pre = false;
          for (int pu = vcu; pu < BATCH * 4 * 8; pu += G) {
            const int bh = pu >> 3, j = pu & 7;
#pragma nounroll
            for (int k2 = 0; k2 < 2; ++k2) {
                const int pun = pu + G; const bool has_next = (k2 == 0) || (pun < BATCH * 4 * 8);
                const int nbh = k2 == 0 ? bh : (pun >> 3), nblk = k2 == 0 ? j : 15 - (pun & 7);
                if (wave < 4) att::attnA_unit<false>(bh >> 2, bh & 3, k2 ? j : 15 - j, (const att::bf16*)QKV, (att::bf16*)MIX, (att::lds_ptr)lds, lam, args.in[9], pre, has_next, nbh >> 2, nbh & 3, nblk);
                else att::attnA_unit<true>(bh >> 2, bh & 3, k2 ? j : 15 - j, (const att::bf16*)QKV, (att::bf16*)MIX, (att::lds_ptr)lds, lam, args.in[9], pre, has_next, nbh >> 2, nbh & 3, nblk);
                pre = has_next;
            }
          } }
        __syncthreads();
        att::attnB_wave(gw, NGW, BATCH * 8 * 64, (const att::bf16*)QKV, (att::bf16*)MIX, (att::lds_ptr)lds + wave * 16384);
    }
#endif
    xcd_barrier(xbar);
#ifndef NO_P3
    { pg8::Gemm g{MIX, W_out, MTOK, DM, DM}; pg8::StaticOrder S; S.init(MTOK, DM, G, bx); pg8::EpiResidLN<true> E{ws};
      pg8::gemm_phase<pg8::EpiResidLN<true>, pg8::StaticOrder, true, true>(lds, g, S, E); }
#endif
    xcd_barrier(xbar);
#ifndef NO_P4
    { pg8::Gemm g{XN, W_gu, MTOK, NGU, DM}; pg8::StaticOrder S; S.init(MTOK, NGU, G, bx); pg8::EpiSwiGLU E{ws};
      pg8::gemm_phase<pg8::EpiSwiGLU, pg8::StaticOrder, true, true>(lds, g, S, E); }
    xcd_barrier(xbar);
    { pg8::Gemm g{HID, W_dn, MTOK, DM, DFF}; pg8::StaticOrder S; S.init(MTOK, DM, G, bx); pg8::EpiResidLN<false> E{ws};
      pg8::gemm_phase<pg8::EpiResidLN<false>, pg8::StaticOrder, true, true>(lds, g, S, E); }
#endif
    xcd_barrier(xbar);
#ifndef NO_P6
    { pg8::Gemm g{XN, W_pg, MTOK, DM, DM}; pg8::StaticOrder S; S.init(MTOK, DM, G, bx); pg8::EpiPle E{ws};
      pg8::gemm_phase<pg8::EpiPle, pg8::StaticOrder, true, true>(lds, g, S, E); }
    xcd_barrier(xbar);
    {
        OPAQUE_TID(tid); const int lane = tid & 63;
        f32x4 gv[4], bv[4];
#pragma unroll
        for (int hf = 0; hf < 2; ++hf)
#pragma unroll
            for (int q = 0; q < 2; ++q) { gv[2 * hf + q] = *(const f32x4*)(args.in[21] + 512 * hf + 8 * lane + 4 * q); bv[2 * hf + q] = *(const f32x4*)(args.in[22] + 512 * hf + 8 * lane + 4 * q); }
        for (int m = gw; m < MTOK; m += 2 * NGW) {
            const int m2 = m + NGW; const bool two = m2 < MTOK;
            const bf16* yr = MIX + (size_t)m * DM + 8 * lane; const bf16* yr2 = MIX + (size_t)(two ? m2 : m) * DM + 8 * lane;
            const pg8::u32x4 ra0 = *(const pg8::u32x4*)(yr), ra1 = *(const pg8::u32x4*)(yr + 512), rb0 = *(const pg8::u32x4*)(yr2), rb1 = *(const pg8::u32x4*)(yr2 + 512);
            const pg8::f32x2 ms = pg8::row_stats<false>(st3, m), ms2 = pg8::row_stats<false>(st3, two ? m2 : m);
            { float* orow = out + (size_t)m * DM + 8 * lane; f32x4 a, b2;
              pg8::unpack8(ra0, a, b2); *(f32x4*)(orow) = (a - ms.x) * ms.y * gv[0] + bv[0]; *(f32x4*)(orow + 4) = (b2 - ms.x) * ms.y * gv[1] + bv[1];
              pg8::unpack8(ra1, a, b2); *(f32x4*)(orow + 512) = (a - ms.x) * ms.y * gv[2] + bv[2]; *(f32x4*)(orow + 516) = (b2 - ms.x) * ms.y * gv[3] + bv[3]; }
            if (two) { float* orow = out + (size_t)m2 * DM + 8 * lane; f32x4 a, b2;
              pg8::unpack8(rb0, a, b2); *(f32x4*)(orow) = (a - ms2.x) * ms2.y * gv[0] + bv[0]; *(f32x4*)(orow + 4) = (b2 - ms2.x) * ms2.y * gv[1] + bv[1];
              pg8::unpack8(rb1, a, b2); *(f32x4*)(orow + 512) = (a - ms2.x) * ms2.y * gv[2] + bv[2]; *(f32x4*)(orow + 516) = (b2 - ms2.x) * ms2.y * gv[3] + bv[3]; }
        }
    }
#endif
}

extern "C" void kernel_launch(void* const* d_in, const int* in_sizes, int n_in, void* d_out, int out_size, void* d_ws, size_t ws_size, hipStream_t stream) {
    static int grid = 0;
    if (grid == 0) {
        if (n_in != 23 || out_size != MTOK * DM || ws_size < WS_END) { fprintf(stderr, "kernel_launch: unexpected problem (n_in %d, out %d, ws %zu)\n", n_in, out_size, ws_size); grid = -1; return; }
        int dev = 0, cus = 0, per_cu = 0;
        (void)hipGetDevice(&dev); (void)hipDeviceGetAttribute(&cus, hipDeviceAttributeMultiprocessorCount, dev);
        if (hipFuncSetAttribute((const void*)fwd_kernel, hipFuncAttributeMaxDynamicSharedMemorySize, LDS_BYTES) != hipSuccess) { fprintf(stderr, "kernel_launch: hipFuncSetAttribute failed\n"); grid = -1; return; }
        if (hipOccupancyMaxActiveBlocksPerMultiprocessor(&per_cu, (const void*)fwd_kernel, NWAVES * 64, LDS_BYTES) != hipSuccess || per_cu < 1) { fprintf(stderr, "kernel_launch: occupancy query says %d\n", per_cu); per_cu = 1; }
        (void)hipGetLastError();
        grid = cus * per_cu;
        fprintf(stderr, "kernel_launch: grid %d (cus %d x %d)\n", grid, cus, per_cu);
    }
    if (grid < 0) return;
    if (hipMemsetAsync((char*)d_ws + WS_CS, 0, (WS_BAR - WS_CS) + 16384, stream) != hipSuccess) { fprintf(stderr, "kernel_launch: hipMemsetAsync failed\n"); return; }
    Args a{};
    for (int i = 0; i < 23; ++i) a.in[i] = (const float*)d_in[i];
    a.out = (float*)d_out; a.ws = (unsigned char*)d_ws;
    void* kargs[] = {&a};
    const hipError_t e = hipLaunchCooperativeKernel((const void*)fwd_kernel, dim3(grid), dim3(NWAVES * 64), kargs, LDS_BYTES, stream);
    if (e != hipSuccess) fprintf(stderr, "kernel_launch: cooperative launch failed: %s (grid %d)\n", hipGetErrorString(e), grid);
}
```

```cpp
#include <hip/hip_runtime.h>
#include <hip/hip_cooperative_groups.h>
#include <cstdio>
#include <cstdint>
#include <cmath>
namespace cg = cooperative_groups;

constexpr int BATCH = 32, SEQ = 2048, DM = 1024, MTOK = BATCH * SEQ, NIN = 3072, DFF = 2816, NGU = 2 * DFF, PLE = 256;
constexpr float LN_EPS = 1e-5f, ALPHA = 1.189207115002721f, LAMBDA_INIT = 0.2f;
constexpr float QSCALE = 0.125f * 1.4426950408889634f;

__device__ __forceinline__ float shx(float v, int lane, int mask) { return __builtin_bit_cast(float, __builtin_amdgcn_ds_bpermute((lane ^ mask) << 2, __builtin_bit_cast(int, v))); }

constexpr size_t MiB = 1u << 20;
constexpr size_t WS_ST0 = 0, WS_ST1 = 512 * 1024, WS_ST2 = 1024 * 1024, WS_CS = 1536 * 1024;
constexpr int CS_IN = 0, BW_IN = 3072, CS_GU = 6144, BW_GU = 6144 + 5632, CS_PG = 6144 + 11264, BW_PG = CS_PG + 1024;
constexpr size_t WS_BAR = 1792 * 1024;
constexpr size_t WS_WIN = 2 * MiB, WS_WOUT = 8 * MiB, WS_WGU = 10 * MiB, WS_WDN = 21 * MiB, WS_WPG = 27 * MiB, WS_WPP = 29 * MiB, WS_ROPE = 30 * MiB;
constexpr size_t WS_ST3 = 832 * MiB;
constexpr size_t WS_XN = 32 * MiB, WS_QKV = 160 * MiB, WS_HID = 160 * MiB  , WS_MIX = 544 * MiB, WS_PB = 672 * MiB, WS_E = 704 * MiB, WS_END = 833 * MiB;
constexpr size_t WS_TBL = 1808 * 1024;

namespace pg8 {
#define PG8_LAS __attribute__((address_space(3)))
typedef unsigned short bf16_t;
typedef short bf16x8 __attribute__((ext_vector_type(8)));
typedef float f32x4 __attribute__((ext_vector_type(4)));
typedef unsigned u32x4 __attribute__((ext_vector_type(4)));
constexpr int BM = 256, BK = 64, HALF = 128, HTB = HALF * BK * 2  , STAGE_BYTES = 8 * HTB, NXCD = 8, WGM = 8;

__host__ __device__ __forceinline__ int lds_byte(int r, int c) { const int st = (r >> 4) * 2 + (c >> 5), rr = r & 15, cc = c & 31, ob = rr * 64 + cc * 2; return st * 1024 + (ob ^ (((ob >> 9) & 1) << 5)); }
__host__ __device__ __forceinline__ void stage_rc(int b, int& R, int& C) { const int st = b / 1024, sb = b % 1024, swz = sb ^ (((sb >> 9) & 1) << 5); R = (st >> 1) * 16 + swz / 64; C = (st & 1) * 32 + (swz % 64) / 2; }
__host__ __device__ __forceinline__ int perm32(int rho) { const int n = rho >> 4, i = rho & 15; return 8 * (i >> 2) + 4 * n + (i & 3); }

struct Unit { int pm, pn; };
struct Gemm { const bf16_t* A; const bf16_t* Bt; int M, N, K; };

struct StaticOrder {
    int nM, nN, nwg, G, c;
    __host__ __device__ void init(int M, int N, int G_, int c_) { nM = M / BM; nN = N / BM; nwg = nM * nN; G = G_; c = c_; }
    __host__ __device__ bool next(int i, Unit& u) const {
        const long L = (long)i * G + c; if (L >= nwg) return false;
        int wgid = (int)L; { const int q = nwg / NXCD, r = nwg % NXCD, xcd = wgid % NXCD, off = wgid / NXCD; wgid = (xcd < r ? xcd * (q + 1) : r * (q + 1) + (xcd - r) * q) + off; }
        const int nig = WGM * nN, gid = wgid / nig, fm = gid * WGM, gsz = (nM - fm) < WGM ? (nM - fm) : WGM;
        u.pm = fm + ((wgid % nig) % gsz); u.pn = (wgid % nig) / gsz; return true;
    }
    __device__ __forceinline__ void a_ready(const Unit&) const {}
    __device__ __forceinline__ void done(const Unit&) const {}
};

__device__ __forceinline__ unsigned cvt_pk_bf16(float lo, float hi) { unsigned r; asm volatile("v_cvt_pk_bf16_f32 %0, %1, %2" : "=v"(r) : "v"(lo), "v"(hi)); return r; }
typedef float f32x2 __attribute__((ext_vector_type(2)));
#define EPI_WS(w) size_t z_ = 0; asm volatile("" : "+s"(z_)); unsigned char* w = ws + z_
#define GPTR(T) __attribute__((address_space(1))) T*

__device__ __forceinline__ u32x4 pack8(const f32x4 a, const f32x4 b) { u32x4 w; w.x = cvt_pk_bf16(a[0], a[1]); w.y = cvt_pk_bf16(a[2], a[3]); w.z = cvt_pk_bf16(b[0], b[1]); w.w = cvt_pk_bf16(b[2], b[3]); return w; }

__device__ __forceinline__ void unpack8(const u32x4 v, f32x4& a, f32x4& b) {
    a[0] = __uint_as_float(v.x << 16); a[1] = __uint_as_float(v.x & 0xffff0000u); a[2] = __uint_as_float(v.y << 16); a[3] = __uint_as_float(v.y & 0xffff0000u);
    b[0] = __uint_as_float(v.z << 16); b[1] = __uint_as_float(v.z & 0xffff0000u); b[2] = __uint_as_float(v.w << 16); b[3] = __uint_as_float(v.w & 0xffff0000u); }

struct EpiQKV {
    static constexpr bool PERM = true, AFTER_DRAIN = false;
    unsigned char* ws;
    __device__ __forceinline__ void operator()(const f32x4 (&acc)[2][2][4][2], const Unit& u, int wr, int wc, int fr, int fq) const {
        EPI_WS(w);
        bf16_t* O = (bf16_t*)(w + WS_QKV); const float* rope = (const float*)(w + WS_ROPE);
        const float* bw = (const float*)(w + WS_CS) + BW_IN;
        const int row0 = u.pm * BM + wr * 64 + fr, colb = u.pn * BM + wc * 64 + 8 * fq, gc = u.pn * BM + wc * 32 + 8 * fq;
        const bool do_rope = u.pn < 4;
        const float sc = (u.pn < 2 || u.pn == 6 || u.pn == 7) ? 0.18033688011112042f : 1.f;
        const f32x4 bwa0 = *(const f32x4*)(bw + gc) * sc, bwa1 = *(const f32x4*)(bw + gc + 4) * sc, bwb0 = *(const f32x4*)(bw + gc + HALF) * sc, bwb1 = *(const f32x4*)(bw + gc + HALF + 4) * sc;
#pragma unroll
        for (int ai = 0; ai < 2; ++ai)
#pragma unroll
            for (int m = 0; m < 4; ++m) {
                const int row = row0 + ai * HALF + m * 16;
                f32x4 a0 = acc[ai][0][m][0] * sc + bwa0, a1 = acc[ai][0][m][1] * sc + bwa1;
                f32x4 b0 = acc[ai][1][m][0] * sc + bwb0, b1 = acc[ai][1][m][1] * sc + bwb1;
                if (do_rope) {
                    const f32x4* rp = (const f32x4*)(rope + (size_t)(row & 2047) * 64 + 8 * fq);
                    const f32x4 c0 = rp[0], c1 = rp[1], s0 = rp[8], s1 = rp[9];
                    const f32x4 na0 = a0 * c0 - b0 * s0, nb0 = b0 * c0 + a0 * s0, na1 = a1 * c1 - b1 * s1, nb1 = b1 * c1 + a1 * s1;
                    a0 = na0; a1 = na1; b0 = nb0; b1 = nb1;
                }
                bf16_t* rowp = O + (size_t)row * 3072 + colb;
                *(u32x4*)(rowp) = pack8(a0, a1);
                *(u32x4*)(rowp + 32) = pack8(b0, b1);
                if ((m & (4 - 1)) == 4 - 1) asm volatile("" ::: "memory");
            }
    }
};
template <bool FIRST> __device__ __forceinline__ f32x2 row_stats(const f32x2* st, int row) {
    const f32x2 v = st[row]; if (FIRST) return v;
    const float mu = v.x * (1.f / 1024.f), var = v.y * (1.f / 1024.f) - mu * mu; return (f32x2){mu, __builtin_amdgcn_rsqf(fmaxf(var, 0.f) + 1e-5f)};
}
template <bool FIRST> struct EpiResidLN {
    static constexpr bool PERM = true, AFTER_DRAIN = false;
    unsigned char* ws;
    __device__ __forceinline__ void operator()(const f32x4 (&acc)[2][2][4][2], const Unit& u, int wr, int wc, int fr, int fq) const {
        EPI_WS(w); const float* const* tb = (const float* const*)(w + WS_TBL);
        const GPTR(const float) base = FIRST ? (const GPTR(const float))tb[0] : nullptr; bf16_t* xn = (bf16_t*)(w + WS_XN); const f32x2* st_in = (const f32x2*)(w + (FIRST ? WS_ST0 : WS_ST1));
        const GPTR(const float) g = (const GPTR(const float))tb[FIRST ? 2 : 11]; const GPTR(const float) b = (const GPTR(const float))tb[FIRST ? 3 : 12]; float* st_out = (float*)(w + (FIRST ? WS_ST1 : WS_ST2));
        const int row0 = u.pm * BM + wr * 64 + fr, col0 = u.pn * BM + wc * 32 + 8 * fq;
        f32x4 gv[2][2], bv[2][2];
#pragma unroll
        for (int bj = 0; bj < 2; ++bj)
#pragma unroll
            for (int n = 0; n < 2; ++n) { gv[bj][n] = *(const GPTR(const f32x4))(g + col0 + bj * HALF + 4 * n); bv[bj][n] = *(const GPTR(const f32x4))(b + col0 + bj * HALF + 4 * n); }
#pragma unroll
        for (int ai = 0; ai < 2; ++ai)
#pragma unroll
            for (int m = 0; m < 4; ++m) {
                const int row = row0 + ai * HALF + m * 16; const size_t off = (size_t)row * 1024 + col0;
                const f32x2 ms = row_stats<FIRST>(st_in, row);
                float rs = 0.f, rq = 0.f;
#pragma unroll
                for (int bj = 0; bj < 2; ++bj) { f32x4 y[2], bs[2];
                    if (FIRST) { bs[0] = *(const GPTR(const f32x4))(base + off + bj * HALF); bs[1] = *(const GPTR(const f32x4))(base + off + bj * HALF + 4); }
                    else unpack8(*(const u32x4*)(xn + off + bj * HALF), bs[0], bs[1]);
#pragma unroll
                    for (int n = 0; n < 2; ++n) { const f32x4 h = (bs[n] - ms.x) * ms.y * gv[bj][n] + bv[bj][n];
                        y[n] = h * 1.189207115002721f + acc[ai][bj][m][n];
                        rs += (y[n][0] + y[n][1]) + (y[n][2] + y[n][3]); rq += (y[n][0] * y[n][0] + y[n][1] * y[n][1]) + (y[n][2] * y[n][2] + y[n][3] * y[n][3]); }
                    *(u32x4*)(xn + off + bj * HALF) = pack8(y[0], y[1]); }
                { const int ln = fq * 16 + fr; rs += shx(rs, ln, 16); rq += shx(rq, ln, 16); float t = (fq & 1) ? rq : rs; t += shx(t, ln, 32); rs = t; rq = t; }
                if (fq < 2) atomicAdd(st_out + 2 * row + fq, fq ? rq : rs);
                if ((m & (4 - 1)) == 4 - 1) asm volatile("" ::: "memory");
            }
    }
};
struct EpiSwiGLU {
    static constexpr bool PERM = true, AFTER_DRAIN = false;
    unsigned char* ws;
    __device__ __forceinline__ void operator()(const f32x4 (&acc)[2][2][4][2], const Unit& u, int wr, int wc, int fr, int fq) const {
        EPI_WS(w);
        bf16_t* O = (bf16_t*)(w + WS_HID); const f32x2* st = (const f32x2*)(w + WS_ST1); const float* cs = (const float*)(w + WS_CS) + CS_GU; const float* bw = (const float*)(w + WS_CS) + BW_GU;
        const int row0 = u.pm * BM + wr * 64 + fr, col0 = u.pn * HALF + wc * 32 + 8 * fq, gc = u.pn * BM + wc * 32 + 8 * fq;
        f32x4 csv[2][2], bwv[2][2];
#pragma unroll
        for (int bj = 0; bj < 2; ++bj)
#pragma unroll
            for (int n = 0; n < 2; ++n) { csv[bj][n] = *(const f32x4*)(cs + gc + bj * HALF + 4 * n); bwv[bj][n] = *(const f32x4*)(bw + gc + bj * HALF + 4 * n); }
#pragma unroll
        for (int ai = 0; ai < 2; ++ai)
#pragma unroll
            for (int m = 0; m < 4; ++m) {
                const int row = row0 + ai * HALF + m * 16;
                const f32x2 ms = row_stats<false>(st, row);
                f32x4 h[2];
#pragma unroll
                for (int n = 0; n < 2; ++n) { const f32x4 g = (acc[ai][0][m][n] - csv[0][n] * ms.x) * ms.y + bwv[0][n], up = (acc[ai][1][m][n] - csv[1][n] * ms.x) * ms.y + bwv[1][n];
#pragma unroll
                    for (int i = 0; i < 4; ++i) { const float e = __builtin_amdgcn_exp2f(-1.4426950408889634f * g[i]); h[n][i] = g[i] * __builtin_amdgcn_rcpf(1.f + e) * up[i]; } }
                *(u32x4*)(O + (size_t)row * 2816 + col0) = pack8(h[0], h[1]);
            }
    }
};
struct EpiPlain {
    static constexpr bool PERM = true, AFTER_DRAIN = false;
    bf16_t* O;
    __device__ __forceinline__ void operator()(const f32x4 (&acc)[2][2][4][2], const Unit& u, int wr, int wc, int fr, int fq) const {
        const int row0 = u.pm * BM + wr * 64 + fr, col0 = u.pn * BM + wc * 32 + 8 * fq;
#pragma unroll
        for (int ai = 0; ai < 2; ++ai)
#pragma unroll
            for (int m = 0; m < 4; ++m)
#pragma unroll
                for (int bj = 0; bj < 2; ++bj) *(u32x4*)(O + (size_t)(row0 + ai * HALF + m * 16) * 1024 + col0 + bj * HALF) = pack8(acc[ai][bj][m][0], acc[ai][bj][m][1]);
    }
};
struct EpiPle {
    static constexpr bool PERM = true, AFTER_DRAIN = false;
    unsigned char* ws;
    __device__ __forceinline__ void operator()(const f32x4 (&acc)[2][2][4][2], const Unit& u, int wr, int wc, int fr, int fq) const {
        EPI_WS(w); const float* const* tb = (const float* const*)(w + WS_TBL);
        const bf16_t* base = (const bf16_t*)(w + WS_XN); bf16_t* out = (bf16_t*)(w + WS_MIX); float* st_out = (float*)(w + WS_ST3); const GPTR(const float) bias = (const GPTR(const float))tb[19]; const bf16_t* E = (const bf16_t*)(w + WS_E);
        const f32x2* st = (const f32x2*)(w + WS_ST2); const float* cs = (const float*)(w + WS_CS) + CS_PG; const float* bw = (const float*)(w + WS_CS) + BW_PG; const GPTR(const float) g = (const GPTR(const float))tb[16]; const GPTR(const float) b = (const GPTR(const float))tb[17];
        const int row0 = u.pm * BM + wr * 64 + fr, col0 = u.pn * BM + wc * 32 + 8 * fq;
        float prs[8], prq[8];
#pragma unroll
        for (int bj = 0; bj < 2; ++bj) {
            const int c = col0 + bj * HALF;
            const f32x4 cs0 = *(const f32x4*)(cs + c), cs1 = *(const f32x4*)(cs + c + 4);
            const f32x4 bb0 = *(const f32x4*)(bw + c) + *(const GPTR(const f32x4))(bias + c), bb1 = *(const f32x4*)(bw + c + 4) + *(const GPTR(const f32x4))(bias + c + 4);
            const f32x4 g0v = *(const GPTR(const f32x4))(g + c), g1v = *(const GPTR(const f32x4))(g + c + 4), b0v = *(const GPTR(const f32x4))(b + c), b1v = *(const GPTR(const f32x4))(b + c + 4);
#pragma unroll
            for (int ai = 0; ai < 2; ++ai)
#pragma unroll
                for (int m = 0; m < 4; ++m) {
                    const int row = row0 + ai * HALF + m * 16; const size_t off = (size_t)row * 1024 + c;
                    const f32x2 ms = row_stats<false>(st, row);
                    const u32x4 ev = *(const u32x4*)(E + off);
                    f32x4 e0, e1; unpack8(ev, e0, e1);
                    const f32x4 z0 = (acc[ai][bj][m][0] - cs0 * ms.x) * ms.y + bb0, z1 = (acc[ai][bj][m][1] - cs1 * ms.x) * ms.y + bb1;
                    f32x4 g0, g1;
#pragma unroll
                    for (int i = 0; i < 4; ++i) { g0[i] = __builtin_amdgcn_rcpf(1.f + __builtin_amdgcn_exp2f(-1.4426950408889634f * z0[i])); g1[i] = __builtin_amdgcn_rcpf(1.f + __builtin_amdgcn_exp2f(-1.4426950408889634f * z1[i])); }
                    f32x4 y0, y1; unpack8(*(const u32x4*)(base + off), y0, y1);
                    const f32x4 h0 = (y0 - ms.x) * ms.y * g0v + b0v, h1 = (y1 - ms.x) * ms.y * g1v + b1v;
                    const f32x4 o0 = h0 * 1.189207115002721f + g0 * e0, o1 = h1 * 1.189207115002721f + g1 * e1;
                    *(u32x4*)(out + off) = pack8(o0, o1);
                    float rs = (o0[0] + o0[1]) + (o0[2] + o0[3]) + (o1[0] + o1[1]) + (o1[2] + o1[3]);
                    float rq = (o0[0] * o0[0] + o0[1] * o0[1]) + (o0[2] * o0[2] + o0[3] * o0[3]) + (o1[0] * o1[0] + o1[1] * o1[1]) + (o1[2] * o1[2] + o1[3] * o1[3]);
                    if (bj == 0) { prs[ai * 4 + m] = rs; prq[ai * 4 + m] = rq; }
                    else { rs += prs[ai * 4 + m]; rq += prq[ai * 4 + m];
                        { const int ln = fq * 16 + fr; rs += shx(rs, ln, 16); rq += shx(rq, ln, 16); float t = (fq & 1) ? rq : rs; t += shx(t, ln, 32); rs = t; rq = t; }
                        if (fq < 2) atomicAdd(st_out + 2 * row + fq, fq ? rq : rs);     }
                    if ((m & (4 - 1)) == 4 - 1) asm volatile("" ::: "memory");
                }
        }
    }
};

template <class Epi, class Sched, bool ALIGN_EPI = false, bool SP2 = false>
__device__ __forceinline__ void gemm_phase(PG8_LAS unsigned char* lds, const Gemm g, const Sched& S, const Epi& E) {
    int tid_ = threadIdx.x; asm volatile("" : "+v"(tid_));
    const int tid = tid_, wid = __builtin_amdgcn_readfirstlane(tid >> 6), lane = tid & 63, wr = wid >> 2, wc = wid & 3, fr = lane & 15, fq = lane >> 4;
    const int K = g.K, nt = K / BK;
    unsigned voffA[2], voffB[2];
#pragma unroll
    for (int i = 0; i < 2; ++i) { int R, C; stage_rc(tid * 16 + i * 8192, R, C); const int Rb = Epi::PERM ? ((R & ~31) + perm32(R & 31)) : R;
        voffA[i] = (unsigned)(R * K + C) * 2u; voffB[i] = (unsigned)(Rb * K + C) * 2u; }
    const size_t kstep = (size_t)(BK * 2);
    const size_t hstep = (size_t)HALF * K * 2;
    const size_t tstep = 2 * hstep;
    const unsigned ldsw = (unsigned)wid * 1024u;
    const int aoff = lds_byte(wr * 64 + fr, fq * 8), boff = lds_byte(wc * 32 + fr, fq * 8);
#define PG8_SA(b, h) (((b) * 2 + (h)) * HTB)
#define PG8_SB(b, h) ((4 + (b) * 2 + (h)) * HTB)
#define PG8_STAGE(bufoff, gbase, voff) do { _Pragma("unroll") for (int _i = 0; _i < 2; ++_i) \
        __builtin_amdgcn_global_load_lds((const unsigned*)((const char*)(gbase) + (voff)[_i]), (PG8_LAS unsigned*)(lds + (bufoff) + ldsw + _i * 8192), 16, 0, 0); } while (0)
#define PG8_LDA(dst, b, h) do { _Pragma("unroll") for (int m = 0; m < 4; ++m) _Pragma("unroll") for (int k = 0; k < 2; ++k) dst[m][k] = *(const PG8_LAS bf16x8*)(lds + PG8_SA(b, h) + aoff + m * 2048 + k * 1024); } while (0)
#define PG8_LDB(dst, b, h) do { _Pragma("unroll") for (int n = 0; n < 2; ++n) _Pragma("unroll") for (int k = 0; k < 2; ++k) dst[n][k] = *(const PG8_LAS bf16x8*)(lds + PG8_SB(b, h) + boff + n * 2048 + k * 1024); } while (0)
#define PG8_MMA(ai, bj, At, Bt) do { __builtin_amdgcn_s_setprio(1); _Pragma("unroll") for (int m = 0; m < 4; ++m) _Pragma("unroll") for (int n = 0; n < 2; ++n) _Pragma("unroll") for (int k = 0; k < 2; ++k) \
        acc[ai][bj][m][n] = __builtin_amdgcn_mfma_f32_16x16x32_bf16(Bt[n][k], At[m][k], acc[ai][bj][m][n], 0, 0, 0); __builtin_amdgcn_s_setprio(0); } while (0)
#define PG8_WAIT_V(n) asm volatile("s_waitcnt vmcnt(" #n ")" ::: "memory")
#define PG8_WAIT_L(n) asm volatile("s_waitcnt lgkmcnt(" #n ")" ::: "memory")
#define PG8_BAR __builtin_amdgcn_s_barrier()
#define PG8_SCHED __builtin_amdgcn_sched_barrier(0)
    Unit cur, nxt; int ui = 0;
    if (!S.next(0, cur)) return;
    f32x4 acc[2][2][4][2];
#pragma unroll
    for (int a = 0; a < 2; ++a)
#pragma unroll
        for (int b = 0; b < 2; ++b)
#pragma unroll
            for (int m = 0; m < 4; ++m)
#pragma unroll
                for (int n = 0; n < 2; ++n) acc[a][b][m][n] = (f32x4){0.f, 0.f, 0.f, 0.f};
    bf16x8 At[4][2], B0[2][2], B1[2][2];
    const char* cA = (const char*)g.A + (size_t)cur.pm * tstep; const char* cB = (const char*)g.Bt + (size_t)cur.pn * tstep;
    S.a_ready(cur);
    if constexpr (SP2) {
        PG8_STAGE(PG8_SB(0, 0), cB, voffB); PG8_STAGE(PG8_SB(0, 1), cB + hstep, voffB); PG8_STAGE(PG8_SA(0, 0), cA, voffA); PG8_STAGE(PG8_SA(0, 1), cA + hstep, voffA);
        if (wr == 1) PG8_BAR;
        PG8_WAIT_V(2); PG8_BAR;
        PG8_STAGE(PG8_SB(1, 0), cB + kstep, voffB); PG8_STAGE(PG8_SA(1, 0), cA + kstep, voffA); PG8_STAGE(PG8_SB(1, 1), cB + hstep + kstep, voffB);
        PG8_WAIT_V(6); PG8_BAR;
    } else {
        PG8_STAGE(PG8_SB(0, 0), cB, voffB); PG8_STAGE(PG8_SA(0, 0), cA, voffA); PG8_STAGE(PG8_SB(0, 1), cB + hstep, voffB); PG8_STAGE(PG8_SA(0, 1), cA + hstep, voffA);
        if (wr == 1) PG8_BAR;
        PG8_WAIT_V(4); PG8_BAR;
        PG8_STAGE(PG8_SB(1, 0), cB + kstep, voffB); PG8_STAGE(PG8_SA(1, 0), cA + kstep, voffA); PG8_STAGE(PG8_SB(1, 1), cB + hstep + kstep, voffB);
        PG8_WAIT_V(6); PG8_BAR;
    }
    for (;;) {
        const bool has_next = S.next(ui + 1, nxt);
        const char* nA = has_next ? (const char*)g.A + (size_t)nxt.pm * tstep : cA; const char* nB = has_next ? (const char*)g.Bt + (size_t)nxt.pn * tstep : cB;
        for (int t = 0; t < nt; t += 2) {
            const bool last = (t == nt - 2);
            const char* a1 = cA + (size_t)(t + 1) * kstep;
            const char* a2 = last ? nA : cA + (size_t)(t + 2) * kstep; const char* b2 = last ? nB : cB + (size_t)(t + 2) * kstep;
            const char* a3 = a2 + kstep; const char* b3 = b2 + kstep;
            if (last && has_next) S.a_ready(nxt);
            if constexpr (SP2) {
            PG8_LDB(B0, 0, 0); PG8_LDB(B1, 0, 1); PG8_SCHED; PG8_LDA(At, 0, 0); PG8_STAGE(PG8_SA(1, 1), a1 + hstep, voffA);
            PG8_WAIT_V(8); PG8_WAIT_L(0); PG8_BAR; PG8_MMA(0, 0, At, B0); PG8_MMA(0, 1, At, B1); PG8_BAR; PG8_SCHED;
            PG8_LDA(At, 0, 1); PG8_STAGE(PG8_SB(0, 0), b2, voffB); PG8_STAGE(PG8_SB(0, 1), b2 + hstep, voffB); PG8_STAGE(PG8_SA(0, 0), a2, voffA);
            PG8_WAIT_V(8); PG8_WAIT_L(0); PG8_BAR; PG8_MMA(1, 0, At, B0); PG8_MMA(1, 1, At, B1); PG8_BAR; PG8_SCHED;
            PG8_LDB(B0, 1, 0); PG8_LDB(B1, 1, 1); PG8_SCHED; PG8_LDA(At, 1, 0); PG8_STAGE(PG8_SA(0, 1), a2 + hstep, voffA);
            PG8_WAIT_V(8); PG8_WAIT_L(0); PG8_BAR; PG8_MMA(0, 0, At, B0); PG8_MMA(0, 1, At, B1); PG8_BAR; PG8_SCHED;
            PG8_LDA(At, 1, 1); PG8_STAGE(PG8_SB(1, 0), b3, voffB); PG8_STAGE(PG8_SB(1, 1), b3 + hstep, voffB); PG8_STAGE(PG8_SA(1, 0), a3, voffA);
            PG8_WAIT_V(8); PG8_WAIT_L(0); PG8_BAR; PG8_MMA(1, 0, At, B0); PG8_MMA(1, 1, At, B1); PG8_BAR; PG8_SCHED;
            } else {
            PG8_LDB(B0, 0, 0); PG8_SCHED; PG8_LDA(At, 0, 0); PG8_STAGE(PG8_SA(1, 1), a1 + hstep, voffA);
            PG8_WAIT_L(8); PG8_BAR; PG8_WAIT_L(0); PG8_MMA(0, 0, At, B0); PG8_BAR; PG8_SCHED;
            PG8_LDB(B1, 0, 1); PG8_STAGE(PG8_SB(0, 0), b2, voffB);
            PG8_BAR; PG8_WAIT_L(0); PG8_MMA(0, 1, At, B1); PG8_BAR;
            PG8_LDA(At, 0, 1); PG8_STAGE(PG8_SA(0, 0), a2, voffA);
            PG8_BAR; PG8_WAIT_L(0); PG8_MMA(1, 0, At, B0); PG8_BAR; PG8_SCHED;
            PG8_STAGE(PG8_SB(0, 1), b2 + hstep, voffB);
            PG8_WAIT_V(6); PG8_BAR; PG8_MMA(1, 1, At, B1); PG8_BAR;
            PG8_LDB(B0, 1, 0); PG8_SCHED; PG8_LDA(At, 1, 0); PG8_STAGE(PG8_SA(0, 1), a2 + hstep, voffA);
            PG8_WAIT_L(8); PG8_BAR; PG8_WAIT_L(0); PG8_MMA(0, 0, At, B0); PG8_BAR; PG8_SCHED;
            PG8_LDB(B1, 1, 1); PG8_STAGE(PG8_SB(1, 0), b3, voffB);
            PG8_BAR; PG8_WAIT_L(0); PG8_MMA(0, 1, At, B1); PG8_BAR;
            PG8_LDA(At, 1, 1); PG8_STAGE(PG8_SA(1, 0), a3, voffA);
            PG8_BAR; PG8_WAIT_L(0); PG8_MMA(1, 0, At, B0); PG8_BAR; PG8_SCHED;
            PG8_STAGE(PG8_SB(1, 1), b3 + hstep, voffB);
            PG8_WAIT_V(6); PG8_BAR; PG8_MMA(1, 1, At, B1); PG8_BAR;
            }
        }
        if constexpr (ALIGN_EPI) { if (wr == 0) PG8_BAR; }
        if constexpr (!Epi::AFTER_DRAIN) { E(acc, cur, wr, wc, fr, fq); S.done(cur); }
        if (!has_next) break;
#pragma unroll
        for (int a = 0; a < 2; ++a)
#pragma unroll
            for (int b = 0; b < 2; ++b)
#pragma unroll
                for (int m = 0; m < 4; ++m)
#pragma unroll
                    for (int n = 0; n < 2; ++n) acc[a][b][m][n] = (f32x4){0.f, 0.f, 0.f, 0.f};
        cur = nxt; cA = nA; cB = nB; ++ui;
        if constexpr (ALIGN_EPI) { if (wr == 1) PG8_BAR; }
    }
    PG8_WAIT_V(0);
    if constexpr (!ALIGN_EPI) { if (wr == 0) PG8_BAR; }
    PG8_BAR;
    if constexpr (Epi::AFTER_DRAIN) { E.fused(acc, cur, wr, wc, fr, fq, lds, wid, lane); S.done(cur); }
#undef PG8_SA
#undef PG8_SB
#undef PG8_STAGE
#undef PG8_LDA
#undef PG8_LDB
#undef PG8_MMA
#undef PG8_WAIT_V
#undef PG8_WAIT_L
#undef PG8_BAR
#undef PG8_SCHED
}
}

namespace att {
#define LAS __attribute__((address_space(3)))
typedef unsigned short bf16;
using bf16x8 = __attribute__((ext_vector_type(8))) short;
using s16x4 = __attribute__((ext_vector_type(4))) short;
using f32x16 = __attribute__((ext_vector_type(16))) float;
using f32x4 = __attribute__((ext_vector_type(4))) float;
using u32x4 = __attribute__((ext_vector_type(4))) unsigned;
typedef LAS const char* lds_cptr;
typedef LAS char* lds_ptr;
typedef short v4i16_t __attribute__((ext_vector_type(4)));
__device__ __forceinline__ int crow(int r, int hi) { return (r & 3) + 8 * (r >> 2) + 4 * hi; }
__device__ __forceinline__ void glds16(const void* gsrc, unsigned lds_dst) { unsigned keep;
    asm volatile("s_mov_b32 %0, m0\n\ts_mov_b32 m0, %2\n\ts_nop 0\n\tglobal_load_lds_dwordx4 %1, off\n\ts_mov_b32 m0, %0" : "=&s"(keep) : "v"(gsrc), "s"(lds_dst) : "memory"); }
typedef float f32x2_t __attribute__((ext_vector_type(2))); typedef __bf16 bf16x2_t __attribute__((ext_vector_type(2)));
__device__ __forceinline__ unsigned cvtpk(float lo, float hi) { f32x2_t v = {lo, hi}; bf16x2_t b = __builtin_convertvector(v, bf16x2_t); return __builtin_bit_cast(unsigned, b); }
__device__ __forceinline__ s16x4 vtr(lds_cptr p) { return __builtin_bit_cast(s16x4, __builtin_amdgcn_ds_read_tr16_b64_v4i16((LAS v4i16_t*)p)); }
__device__ __forceinline__ float partner32(float x, int hi) { auto rr = __builtin_amdgcn_permlane32_swap(__float_as_uint(x), __float_as_uint(x), false, false); return __uint_as_float(hi ? rr[0] : rr[1]); }

__device__ __forceinline__ void qkt64(f32x16& p0, f32x16& p1, lds_cptr Kslot, const bf16x8* qr, int r32, int hi, const f32x16 init = f32x16{}) {
    lds_cptr kb = Kslot + r32 * 128; const int g = (r32 >> 1) & 7;
    p0 = init; p1 = init;
#pragma unroll
    for (int d0 = 0; d0 < 4; ++d0) {
        const int off = ((2 * d0 + hi) ^ g) << 4;
        const bf16x8 b0 = *(const LAS bf16x8*)(kb + off);
        const bf16x8 b1 = *(const LAS bf16x8*)(kb + off + 4096);
        p0 = __builtin_amdgcn_mfma_f32_32x32x16_bf16(b0, qr[d0], p0, 0, 0, 0);
        p1 = __builtin_amdgcn_mfma_f32_32x32x16_bf16(b1, qr[d0], p1, 0, 0, 0);
    }
}
__device__ __forceinline__ void pv32(f32x16& o, lds_cptr vb, const u32x4 pw0, const u32x4 pw1, const u32x4 pw2, const u32x4 pw3) {
    s16x4 lo[4], hi[4];
#pragma unroll
    for (int ks = 0; ks < 4; ++ks) { lo[ks] = vtr(vb + ks * 1024); hi[ks] = vtr(vb + ks * 1024 + 512); }
#define PKV(k) (bf16x8){lo[k][0], lo[k][1], lo[k][2], lo[k][3], hi[k][0], hi[k][1], hi[k][2], hi[k][3]}
    o = __builtin_amdgcn_mfma_f32_32x32x16_bf16(__builtin_bit_cast(bf16x8, pw0), PKV(0), o, 0, 0, 0);
    o = __builtin_amdgcn_mfma_f32_32x32x16_bf16(__builtin_bit_cast(bf16x8, pw1), PKV(1), o, 0, 0, 0);
    o = __builtin_amdgcn_mfma_f32_32x32x16_bf16(__builtin_bit_cast(bf16x8, pw2), PKV(2), o, 0, 0, 0);
    o = __builtin_amdgcn_mfma_f32_32x32x16_bf16(__builtin_bit_cast(bf16x8, pw3), PKV(3), o, 0, 0, 0);
#undef PKV
}
template <int NB> __device__ __forceinline__ void pvks(f32x16 (&o)[NB], lds_cptr vb, int ks, const u32x4 pw) {
    s16x4 lo[NB], hi[NB];
#pragma unroll
    for (int d = 0; d < NB; ++d) { lo[d] = vtr(vb + d * 4096 + ks * 1024); hi[d] = vtr(vb + d * 4096 + ks * 1024 + 512); }
#pragma unroll
    for (int d = 0; d < NB; ++d) o[d] = __builtin_amdgcn_mfma_f32_32x32x16_bf16(__builtin_bit_cast(bf16x8, pw), (bf16x8){lo[d][0], lo[d][1], lo[d][2], lo[d][3], hi[d][0], hi[d][1], hi[d][2], hi[d][3]}, o[d], 0, 0, 0);
}
#define ATT_WAIT_BAR() asm volatile("s_waitcnt vmcnt(0) lgkmcnt(0)\n\ts_barrier" ::: "memory")

__device__ __forceinline__ float max3f(float a, float b, float c) { float r; asm("v_max3_f32 %0, %1, %2, %3" : "=v"(r) : "v"(a), "v"(b), "v"(c)); return r; }
__device__ __forceinline__ float max2f(float a, float b) { float r; asm("v_max_f32_e32 %0, %1, %2" : "=v"(r) : "v"(a), "v"(b)); return r; }
__device__ __forceinline__ float rowmax32(f32x16& a, f32x16& b, int hi) {
    asm volatile("s_nop 15\n\ts_nop 7" : "+v"(a), "+v"(b));
    float m0 = max3f(a[0], a[1], b[0]), m1 = max3f(a[2], a[3], b[1]); m0 = max3f(m0, b[2], b[3]);
#pragma unroll
    for (int r = 4; r < 16; r += 4) { m0 = max3f(m0, a[r], a[r + 1]); m1 = max3f(m1, a[r + 2], a[r + 3]); m0 = max3f(m0, b[r], b[r + 1]); m1 = max3f(m1, b[r + 2], b[r + 3]); }
    const float mx = max2f(m0, m1);
    return max2f(mx, partner32(mx, hi));
}
constexpr int A_BUF = 32768;
constexpr int A_STAGE = 65536  , A_STAGE_W = 132 * 32 * 4;
constexpr int A_WSF = A_STAGE + 4 * A_STAGE_W;
static_assert(A_WSF + 2048 <= 147456 - 1024, "attention LDS map");

template <bool SKEW> __device__ __forceinline__ void attnA_unit(int b, int h, int blk, const bf16* __restrict__ QKV, bf16* __restrict__ MIX, lds_ptr lds, float lam, const float* __restrict__ subg,
                                                               bool pre, bool has_next, int nb, int nh, int nblk) {
    int tid_ = threadIdx.x; asm volatile("" : "+v"(tid_));
    const int tid = tid_, lane = tid & 63, r32 = lane & 31, hi = lane >> 5; const int wid = __builtin_amdgcn_readfirstlane(tid >> 6);
    const int mp = wid >> 2, wq = wid & 3;
    const long rowbase = (long)b * SEQ; const int q0 = blk * 128;
    const unsigned lds0 = (unsigned)(uintptr_t)lds;
    LAS float* wsf = (LAS float*)(lds + A_WSF) + wid * 64;
    const bf16* Qw = QKV + (rowbase + q0 + wq * 32 + r32) * 3072 + (2 * h + mp) * 64;
    bf16x8 qr[4];
#pragma unroll
    for (int d0 = 0; d0 < 4; ++d0) qr[d0] = *reinterpret_cast<const bf16x8*>(Qw + d0 * 16 + hi * 8);
    const int NT = 2 * blk + 2, my_nt = (wq < 2) ? NT - 1 : NT;
    const bf16* ksrc0 = QKV + (rowbase + 8 * wid + (lane >> 3)) * 3072 + 512 + (2 * h) * 64 + (((lane & 7) ^ (4 * (wid & 1) + (lane >> 4))) << 3);
    const bf16* vsrc0 = QKV + (rowbase + 16 * (wid & 3) + (lane >> 2)) * 3072 + 1024 + h * 128 + (wid >> 2) * 32 + (lane & 3) * 8;
#define A_DMA_FROM(KS, VS, t, buf) do { const long go_ = (long)(t) * 64 * 3072; const unsigned lb_ = lds0 + (unsigned)(buf) * A_BUF + (unsigned)wid * 1024u; \
        glds16((KS) + go_, (unsigned)__builtin_amdgcn_readfirstlane(lb_)); glds16((KS) + go_ + 64, (unsigned)__builtin_amdgcn_readfirstlane(lb_ + 8192u)); \
        glds16((VS) + go_, (unsigned)__builtin_amdgcn_readfirstlane(lb_ + 16384u)); glds16((VS) + go_ + 64, (unsigned)__builtin_amdgcn_readfirstlane(lb_ + 16384u + 8192u)); } while (0)
#define A_DMA(t, buf) A_DMA_FROM(ksrc0, vsrc0, t, buf)
    const int vlane = ((lane >> 4) & 1) * 32 + (lane & 3) * 8 + (4 * hi + ((lane & 15) >> 2)) * 64;
    float mref = 0.f, lrun = 0.f; f32x16 o[4];
#pragma unroll
    for (int d = 0; d < 4; ++d) o[d] = f32x16{};
    if constexpr (SKEW) __builtin_amdgcn_s_setprio(1);
    if (!pre) { A_DMA(0, 0); A_DMA(1, 1); }
    ATT_WAIT_BAR();
    f32x16 sa0, sa1, sb0, sb1; qkt64(sa0, sa1, (lds_cptr)lds + mp * 8192, qr, r32, hi);
    float mx = rowmax32(sa0, sa1, hi);
    int st_prev = 3 * A_BUF, st_cur = 0, st_nxt = A_BUF, st_nn = 2 * A_BUF;
    u32x4 pw0, pw1, pw2, pw3;
#define A_RESC(t) do { \
        if ((t) == 0) mref = mx; \
        else if (__any(mx - mref > 8.f)) { \
            const float dl_ = fmaxf(mx - mref, 0.f), f_ = __builtin_amdgcn_exp2f(-dl_); mref += dl_; lrun *= f_; \
            if (hi == 0) wsf[r32] = f_; \
            asm volatile("s_waitcnt lgkmcnt(0)" ::: "memory"); \
            _Pragma("unroll") for (int rq = 0; rq < 4; ++rq) { const f32x4 fv = *(const LAS f32x4*)(wsf + 8 * rq + 4 * hi); \
                _Pragma("unroll") for (int d = 0; d < 4; ++d) { o[d][4 * rq + 0] *= fv[0]; o[d][4 * rq + 1] *= fv[1]; o[d][4 * rq + 2] *= fv[2]; o[d][4 * rq + 3] *= fv[3]; } } \
        } } while (0)
#define A_WBAR(t) do { if ((t) > 0) ATT_WAIT_BAR(); } while (0)
#define A_ISSUE(t) do { if ((t) + 2 < NT) A_DMA((t) + 2, st_nn / A_BUF); } while (0)
#define A_BAR(t) do { A_WBAR(t); A_ISSUE(t); } while (0)
#define A_ROT() do { const int tmp_ = st_prev; st_prev = st_cur; st_cur = st_nxt; st_nxt = st_nn; st_nn = tmp_; } while (0)
#define A_PW(S, B) (u32x4){cvtpk(S[B], S[B + 1]), cvtpk(S[B + 2], S[B + 3]), cvtpk(S[B + 4], S[B + 5]), cvtpk(S[B + 6], S[B + 7])}
#define A_EXPH(S) _Pragma("unroll") for (int r = 0; r < 16; r += 2) { S[r] = __builtin_amdgcn_exp2f(S[r] - mref); S[r + 1] = __builtin_amdgcn_exp2f(S[r + 1] - mref); ps2[0] += S[r]; ps2[0] += S[r + 1]; }
#define A_STEADY(TT, SA0, SA1, SB0, SB1) do { \
        lds_cptr Vslot = (lds_cptr)lds + st_cur + 16384 + vlane; \
        qkt64(SB0, SB1, (lds_cptr)lds + st_nxt + mp * 8192, qr, r32, hi); \
        A_ISSUE(TT); \
        f32x2_t ps2 = {0.f, 0.f}; A_EXPH(SA0); pw0 = A_PW(SA0, 0); pw1 = A_PW(SA0, 8); \
        __builtin_amdgcn_sched_barrier(0); \
        pvks<4>(o, Vslot, 0, pw0); pvks<4>(o, Vslot, 1, pw1); \
        A_EXPH(SA1); lrun += ps2[0] + ps2[1]; pw2 = A_PW(SA1, 0); pw3 = A_PW(SA1, 8); \
        __builtin_amdgcn_sched_barrier(0); \
        pvks<4>(o, Vslot, 2, pw2); pvks<4>(o, Vslot, 3, pw3); \
        mx = rowmax32(SB0, SB1, hi); } while (0)
#define A_LAST(SA0, SA1) do { \
        lds_cptr Vslot = (lds_cptr)lds + st_cur + 16384 + vlane; \
        f32x2_t ps2 = {0.f, 0.f}; A_EXPH(SA0); pw0 = A_PW(SA0, 0); pw1 = A_PW(SA0, 8); \
        __builtin_amdgcn_sched_barrier(0); \
        pvks<4>(o, Vslot, 0, pw0); pvks<4>(o, Vslot, 1, pw1); \
        A_EXPH(SA1); lrun += ps2[0] + ps2[1]; pw2 = A_PW(SA1, 0); pw3 = A_PW(SA1, 8); \
        __builtin_amdgcn_sched_barrier(0); \
        pvks<4>(o, Vslot, 2, pw2); pvks<4>(o, Vslot, 3, pw3); } while (0)
#define A_PVPREV() do { lds_cptr Vp_ = (lds_cptr)lds + st_prev + 16384 + vlane; __builtin_amdgcn_sched_barrier(0); pvks<4>(o, Vp_, 0, pw0); pvks<4>(o, Vp_, 1, pw1); __builtin_amdgcn_sched_barrier(0); pvks<4>(o, Vp_, 2, pw2); pvks<4>(o, Vp_, 3, pw3); __builtin_amdgcn_sched_barrier(0); } while (0)
#define A_QKEXP(SA0, SA1, SB0, SB1) do { \
        qkt64(SB0, SB1, (lds_cptr)lds + st_nxt + mp * 8192, qr, r32, hi); \
        f32x2_t ps2 = {0.f, 0.f}; A_EXPH(SA0); A_EXPH(SA1); lrun += ps2[0] + ps2[1]; \
        pw0 = A_PW(SA0, 0); pw1 = A_PW(SA0, 8); pw2 = A_PW(SA1, 0); pw3 = A_PW(SA1, 8); \
        mx = rowmax32(SB0, SB1, hi); } while (0)
#define A_EXPONLY(SA0, SA1) do { \
        f32x2_t ps2 = {0.f, 0.f}; A_EXPH(SA0); A_EXPH(SA1); lrun += ps2[0] + ps2[1]; \
        pw0 = A_PW(SA0, 0); pw1 = A_PW(SA0, 8); pw2 = A_PW(SA1, 0); pw3 = A_PW(SA1, 8); } while (0)
#define A_BODY1(t, SA0, SA1, SB0, SB1) do { \
        A_WBAR(t); \
        if ((t) >= 1 && (t) - 1 < my_nt) { A_PVPREV(); } \
        A_ISSUE(t); \
        if ((t) < my_nt) { A_RESC(t); if ((t) + 1 < my_nt) { A_QKEXP(SA0, SA1, SB0, SB1); } else { A_EXPONLY(SA0, SA1); } } \
        A_ROT(); } while (0)
    if constexpr (!SKEW) {
        int t = 0;
        for (; t + 2 < my_nt; t += 2) {
            A_RESC(t); A_WBAR(t); A_STEADY(t, sa0, sa1, sb0, sb1); A_ROT();
            A_RESC(t + 1); A_WBAR(t + 1); A_STEADY(t + 1, sb0, sb1, sa0, sa1); A_ROT();
        }
        if (my_nt - t == 2) { A_RESC(t); A_WBAR(t); A_STEADY(t, sa0, sa1, sb0, sb1); A_ROT(); ++t; A_RESC(t); A_BAR(t); A_LAST(sb0, sb1); A_ROT(); ++t; }
        else { A_RESC(t); A_BAR(t); A_LAST(sa0, sa1); A_ROT(); ++t; }
        for (; t < NT; ++t) { A_BAR(t); A_ROT(); }
    } else {
        for (int t = 0; t < NT; t += 2) { A_BODY1(t, sa0, sa1, sb0, sb1); A_BODY1(t + 1, sb0, sb1, sa0, sa1); }
        if (NT - 1 < my_nt) { A_PVPREV(); }
    }
#undef A_RESC
#undef A_BAR
#undef A_WBAR
#undef A_ISSUE
#undef A_ROT
#undef A_PW
#undef A_EXPH
#undef A_STEADY
#undef A_LAST
#undef A_PVPREV
#undef A_QKEXP
#undef A_EXPONLY
#undef A_BODY1
    if constexpr (SKEW) __builtin_amdgcn_s_setprio(0);
    ATT_WAIT_BAR();
#define A_LDS_BAR() asm volatile("s_waitcnt lgkmcnt(0)\n\ts_barrier" ::: "memory")
    if (has_next) {
        const long nrow = (long)nb * SEQ;
        const bf16* ksn = QKV + (nrow + 8 * wid + (lane >> 3)) * 3072 + 512 + (2 * nh) * 64 + (((lane & 7) ^ (4 * (wid & 1) + (lane >> 4))) << 3);
        const bf16* vsn = QKV + (nrow + 16 * (wid & 3) + (lane >> 2)) * 3072 + 1024 + nh * 128 + (wid >> 2) * 32 + (lane & 3) * 8;
        A_DMA_FROM(ksn, vsn, 0, 0); A_DMA_FROM(ksn, vsn, 1, 1);
    }
#undef A_DMA
#undef A_DMA_FROM
    { const float lt = lrun + partner32(lrun, hi); if (hi == 0) wsf[32 + r32] = 1.f / lt; }
    asm volatile("s_waitcnt lgkmcnt(0)" ::: "memory");
#pragma unroll
    for (int rq = 0; rq < 4; ++rq) { const f32x4 fv = *(const LAS f32x4*)(wsf + 32 + 8 * rq + 4 * hi);
#pragma unroll
        for (int d = 0; d < 4; ++d) { o[d][4 * rq + 0] *= fv[0]; o[d][4 * rq + 1] *= fv[1]; o[d][4 * rq + 2] *= fv[2]; o[d][4 * rq + 3] *= fv[3]; } }
    LAS f32x4* xb = (LAS f32x4*)(lds + A_STAGE);
    if (mp == 1) {
#pragma unroll
        for (int d = 0; d < 4; ++d)
#pragma unroll
            for (int rq = 0; rq < 4; ++rq) xb[((d * 4 + rq) * 4 + wq) * 64 + lane] = (f32x4){o[d][4 * rq], o[d][4 * rq + 1], o[d][4 * rq + 2], o[d][4 * rq + 3]};
    }
    A_LDS_BAR();
    if (mp == 0) {
#pragma unroll
        for (int d = 0; d < 4; ++d)
#pragma unroll
            for (int rq = 0; rq < 4; ++rq) { const f32x4 x2 = xb[((d * 4 + rq) * 4 + wq) * 64 + lane];
#pragma unroll
                for (int i = 0; i < 4; ++i) o[d][4 * rq + i] -= lam * x2[i]; }
    }
    A_LDS_BAR();
    if (mp == 0) {
        LAS float* stg = (LAS float*)(lds + A_STAGE + wq * A_STAGE_W);
#pragma unroll
        for (int d = 0; d < 4; ++d)
#pragma unroll
            for (int r = 0; r < 16; ++r) stg[crow(r, hi) * 132 + d * 32 + r32] = o[d][r];
        asm volatile("s_waitcnt lgkmcnt(0)" ::: "memory");
        const int row = lane >> 1, half = lane & 1;
        f32x4 v[16]; float ss = 0.f;
#pragma unroll
        for (int i = 0; i < 16; ++i) { v[i] = *(const LAS f32x4*)(stg + row * 132 + half * 64 + 4 * i); ss += (v[i][0] * v[i][0] + v[i][1] * v[i][1]) + (v[i][2] * v[i][2] + v[i][3] * v[i][3]); }
        ss += shx(ss, lane, 1);
        const float rs = (1.f - LAMBDA_INIT) / sqrtf(ss * (1.f / 128.f) + LN_EPS);
        bf16* orow = MIX + (rowbase + q0 + wq * 32 + row) * 1024 + h * 128 + half * 64;
        const f32x4* gp = (const f32x4*)(subg + half * 64);
#pragma unroll
        for (int i = 0; i < 8; ++i) { const f32x4 g0 = gp[2 * i], g1 = gp[2 * i + 1]; const f32x4 a = v[2 * i] * g0 * rs, c = v[2 * i + 1] * g1 * rs;
            u32x4 w; w.x = cvtpk(a[0], a[1]); w.y = cvtpk(a[2], a[3]); w.z = cvtpk(c[0], c[1]); w.w = cvtpk(c[2], c[3]); *(u32x4*)(orow + 8 * i) = w; }
        asm volatile("s_waitcnt lgkmcnt(0)" ::: "memory");
    }
#undef A_LDS_BAR
}

__device__ __forceinline__ void attnB_wave(int gw, int NGW, int NU, const bf16* __restrict__ QKV, bf16* __restrict__ MIX, lds_ptr wl  ) {
    int tid_ = threadIdx.x; asm volatile("" : "+v"(tid_));
    const int lane = tid_ & 63, r32 = lane & 31, hi = lane >> 5;
    const unsigned wl0 = (unsigned)__builtin_amdgcn_readfirstlane((unsigned)(uintptr_t)wl);
    const int kce = ((lane & 7) ^ (lane >> 4)) << 3, kco = ((lane & 7) ^ (4 + (lane >> 4))) << 3;
    int u = gw; if (u >= NU) return;
    long rowbase; int q0, hh, jd; const bf16* ksrc; const bf16* vsrc; bf16x8 qr[4], qn[4];
#define B_SETUP(uu, QF) do { const int bh_ = (uu) >> 6; hh = bh_ & 7; rowbase = (long)(bh_ >> 3) * SEQ; jd = ((uu) + 8 * (bh_ >> 5)) & 63  ; q0 = jd * 32; \
        const bf16* Qw_ = QKV + (rowbase + q0 + r32) * 3072 + 1536 + hh * 64; \
        _Pragma("unroll") for (int d0 = 0; d0 < 4; ++d0) QF[d0] = *reinterpret_cast<const bf16x8*>(Qw_ + d0 * 16 + hi * 8); \
        ksrc = QKV + (rowbase + (lane >> 3)) * 3072 + 2048 + hh * 64; vsrc = QKV + (rowbase + (lane >> 2)) * 3072 + 2560 + hh * 64 + (lane & 3) * 8; } while (0)
    const int vlane = ((lane >> 4) & 1) * 32 + (lane & 3) * 8 + (4 * hi + ((lane & 15) >> 2)) * 64;
    const int kgl = (r32 >> 1) & 7;
#define B_DMA(j, bo) do { const long go_ = (long)(j) * 32 * 3072; \
        _Pragma("unroll") for (int c_ = 0; c_ < 4; ++c_) glds16(ksrc + go_ + (long)(8 * c_) * 3072 + ((c_ & 1) ? kco : kce), wl0 + (bo) + c_ * 1024); \
        _Pragma("unroll") for (int p_ = 0; p_ < 4; ++p_) glds16(vsrc + go_ + (long)(16 * (p_ & 1)) * 3072 + (p_ >> 1) * 32, wl0 + (bo) + 4096 + p_ * 1024); } while (0)
    B_SETUP(u, qr); B_DMA(jd, 8192);
    for (;;) {
    f32x16 o[2]; o[0] = f32x16{}; o[1] = f32x16{};
    float C = 1.f, R = 0.f;
    int bo = 8192;
    for (int j = jd; j >= 0; --j) {
        if (j > 0) { asm volatile("s_waitcnt lgkmcnt(0)" ::: "memory"); B_DMA(j - 1, bo ^ 8192); asm volatile("s_waitcnt vmcnt(8)" ::: "memory"); }
        else asm volatile("s_waitcnt vmcnt(0)" ::: "memory");
        lds_cptr Kb = (lds_cptr)wl + bo + r32 * 128;
        f32x16 p = f32x16{};
#pragma unroll
        for (int d0 = 0; d0 < 4; ++d0) p = __builtin_amdgcn_mfma_f32_32x32x16_bf16(*(const LAS bf16x8*)(Kb + (((2 * d0 + hi) ^ kgl) << 4)), qr[d0], p, 0, 0, 0);
        const int qloc = q0 + r32 - 32 * j;
        float beta[16], omb[16];
#pragma unroll
        for (int r = 0; r < 16; ++r) {
            const float zz = __builtin_amdgcn_fmed3f(p[r], -126.f, 3.0e38f), e = __builtin_amdgcn_exp2f(-zz), r0 = __builtin_amdgcn_rcpf(1.f + e);
            beta[r] = r0; omb[r] = e * r0;
        }
        if (j == jd) {
#pragma unroll
            for (int r = 0; r < 16; ++r) { const bool valid = crow(r, hi) < qloc; beta[r] = valid ? beta[r] : 0.f; omb[r] = valid ? omb[r] : 1.f; }
        }
        float insuf[16], gp[4], pg[4];
#pragma unroll
        for (int g = 0; g < 4; ++g) { insuf[4 * g + 3] = 1.f; insuf[4 * g + 2] = omb[4 * g + 3]; insuf[4 * g + 1] = insuf[4 * g + 2] * omb[4 * g + 2]; insuf[4 * g] = insuf[4 * g + 1] * omb[4 * g + 1]; gp[g] = insuf[4 * g] * omb[4 * g]; }
#pragma unroll
        for (int g = 0; g < 4; ++g) pg[g] = partner32(gp[g], hi);
        float acc = C, S[4];
#pragma unroll
        for (int g = 3; g >= 0; --g) { S[g] = hi ? acc : acc * pg[g]; acc *= gp[g] * pg[g]; }
        C = acc; R = __builtin_amdgcn_logf(acc);
#pragma unroll
        for (int r = 0; r < 16; ++r) p[r] = beta[r] * (insuf[r] * S[r >> 2]);
        const u32x4 pw0 = {cvtpk(p[0], p[1]), cvtpk(p[2], p[3]), cvtpk(p[4], p[5]), cvtpk(p[6], p[7])}, pw1 = {cvtpk(p[8], p[9]), cvtpk(p[10], p[11]), cvtpk(p[12], p[13]), cvtpk(p[14], p[15])};
        lds_cptr vb = (lds_cptr)wl + bo + 4096 + vlane;
#pragma unroll
        for (int d = 0; d < 2; ++d) {
            const s16x4 l0 = vtr(vb + d * 2048), h0 = vtr(vb + d * 2048 + 512), l1 = vtr(vb + d * 2048 + 1024), h1 = vtr(vb + d * 2048 + 1536);
            o[d] = __builtin_amdgcn_mfma_f32_32x32x16_bf16(__builtin_bit_cast(bf16x8, pw0), (bf16x8){l0[0], l0[1], l0[2], l0[3], h0[0], h0[1], h0[2], h0[3]}, o[d], 0, 0, 0);
            o[d] = __builtin_amdgcn_mfma_f32_32x32x16_bf16(__builtin_bit_cast(bf16x8, pw1), (bf16x8){l1[0], l1[1], l1[2], l1[3], h1[0], h1[1], h1[2], h1[3]}, o[d], 0, 0, 0);
        }
        bo ^= 8192;
        if (!__any(R > -150.f)) break;
    }
    asm volatile("s_waitcnt vmcnt(0) lgkmcnt(0)" ::: "memory");
    const long orow0 = rowbase + q0; const int oh = hh;
    const int un = u + NGW;
    if (un < NU) { B_SETUP(un, qn); B_DMA(jd, 8192); }
    LAS bf16* stg = (LAS bf16*)wl;
#pragma unroll
    for (int r = 0; r < 16; ++r) { const int orow = crow(r, hi);
#pragma unroll
        for (int d0 = 0; d0 < 2; ++d0) stg[orow * 64 + d0 * 32 + r32] = (bf16)(cvtpk(o[d0][r], 0.f) & 0xffffu); }
    asm volatile("s_waitcnt lgkmcnt(0)" ::: "memory");
    bf16* Ow = MIX + orow0 * 1024 + 512 + oh * 64;
#pragma unroll
    for (int i = 0; i < 4; ++i) { const int row = i * 8 + (lane >> 3), ch = lane & 7; const u32x4 v = *(const LAS u32x4*)(stg + row * 64 + ch * 8); *(u32x4*)(Ow + (long)row * 1024 + ch * 8) = v; }
    asm volatile("s_waitcnt lgkmcnt(0)" ::: "memory");
    if (un >= NU) break;
    u = un;
#pragma unroll
    for (int d0 = 0; d0 < 4; ++d0) qr[d0] = qn[d0];
    }
#undef B_DMA
#undef B_SETUP
}
#undef LAS
}

constexpr int LDS_BYTES = 147456;
constexpr int NWAVES = 8;

#define GAS __attribute__((address_space(1)))
#define LAS __attribute__((address_space(3)))
typedef unsigned short bf16;
typedef unsigned v4u __attribute__((ext_vector_type(4)));
typedef float f32x4 __attribute__((ext_vector_type(4)));
#define LDS_WAIT() asm volatile("s_waitcnt lgkmcnt(0)" ::: "memory")
__device__ __forceinline__ unsigned f2bf(float f) { unsigned u = __builtin_bit_cast(unsigned, f); return (u + 0x7fffu + ((u >> 16) & 1u)) >> 16; }
__device__ __forceinline__ unsigned pk2(float lo, float hi) { return f2bf(lo) | (f2bf(hi) << 16); }
__device__ __forceinline__ float wave_sum(float v, int lane) {
#pragma unroll
    for (int o = 1; o < 64; o <<= 1) v += shx(v, lane, o);
    return v;
}
#define XB_TMO      128
#define XB_XCNT(j)  (256  + 64 * (j))
#define XB_XSUB(j)  (1280 + 64 * (j))
#define XB_XGEN(j)  (2304 + 64 * (j))
#define XB_TOP      3328
#define XB_TOPGEN   3392
#define XCD_BAR_WORDS 3456
#define XB_SPIN_CAP (1u << 18)

__device__ __forceinline__ unsigned xb_ld(unsigned* p)              { return __hip_atomic_load(p, __ATOMIC_RELAXED, __HIP_MEMORY_SCOPE_AGENT); }
__device__ __forceinline__ unsigned xb_add(unsigned* p, unsigned v) { return __hip_atomic_fetch_add(p, v, __ATOMIC_RELAXED, __HIP_MEMORY_SCOPE_AGENT); }
__device__ __forceinline__ unsigned xb_xcc_id() { return (unsigned)__builtin_amdgcn_s_getreg((3 << 11) | 20) & 0xFu; }
#define XB_SPIN(cond, bar) do { unsigned _sp = 0; while (cond) { __builtin_amdgcn_s_sleep(1); \
    if ((++_sp & 255u) == 0u) { if (xb_ld(&(bar)[XB_TMO])) break; if (_sp > XB_SPIN_CAP) { atomicAdd(&(bar)[XB_TMO], 1u); break; } } } } while (0)

struct XcdBarrier {
    unsigned* bar; unsigned x;
    volatile LAS unsigned* st;
};

__device__ __forceinline__ XcdBarrier xcd_barrier_post(unsigned* bar, volatile LAS unsigned* st) {
    XcdBarrier b; b.bar = bar; b.x = xb_xcc_id(); b.st = st;
    if (threadIdx.x == 0) (void)xb_add(&bar[XB_XCNT(b.x)], 1u);
    return b;
}
__device__ __forceinline__ void xcd_barrier_complete(unsigned* bar, unsigned x, unsigned& nloc, unsigned& nx) {
    const unsigned G = gridDim.x * gridDim.y * gridDim.z;
    unsigned sum, cnt, mine, sp = 0u;
    for (;;) {
        sum = 0u; cnt = 0u; mine = 0u;
#pragma unroll
        for (unsigned j = 0; j < 16; ++j) { const unsigned c = xb_ld(&bar[XB_XCNT(j)]); sum += c; cnt += (c > 0u) ? 1u : 0u; mine = (j == x) ? c : mine; }
        if (sum == G) break;
        __builtin_amdgcn_s_sleep(1);
        if ((++sp & 255u) == 0u) { if (xb_ld(&bar[XB_TMO])) break; if (sp > XB_SPIN_CAP) { atomicAdd(&bar[XB_TMO], 1u); break; } }
    }
    nloc = mine > 0u ? mine : 1u; nx = cnt > 0u ? cnt : 1u;
}

__device__ __forceinline__ void xcd_barrier(const XcdBarrier& b) {
    asm volatile("s_waitcnt vmcnt(0)" ::: "memory");
    __syncthreads();
    if (threadIdx.x == 0) {
        unsigned* bar = b.bar;
        __builtin_amdgcn_s_waitcnt(0);
        unsigned nloc = b.st[0], nx = b.st[1];
        if (nloc == 0u) { xcd_barrier_complete(bar, b.x, nloc, nx); b.st[0] = nloc; b.st[1] = nx; }
        const unsigned old = xb_add(&bar[XB_XSUB(b.x)], 1u);
        const unsigned gen = old / nloc;
        if (old + 1u == (gen + 1u) * nloc) {
            __builtin_amdgcn_fence(__ATOMIC_RELEASE, "agent");
            asm volatile("s_waitcnt vmcnt(0)" ::: "memory");
            const unsigned og = xb_add(&bar[XB_TOP], 1u);
            const unsigned tg = og / nx;
            if (og + 1u == (tg + 1u) * nx) xb_add(&bar[XB_TOPGEN], 1u);
            else XB_SPIN(xb_ld(&bar[XB_TOPGEN]) == tg, bar);
            __builtin_amdgcn_fence(__ATOMIC_ACQUIRE, "agent");
            xb_add(&bar[XB_XGEN(b.x)], 1u);
            asm volatile("s_waitcnt vmcnt(0)" ::: "memory");
        } else {
            XB_SPIN(xb_ld(&bar[XB_XGEN(b.x)]) == gen, bar);
            __builtin_amdgcn_fence(__ATOMIC_ACQUIRE, "agent");
            asm volatile("s_waitcnt vmcnt(0)" ::: "memory");
        }
    }
    __syncthreads();
}

__device__ __forceinline__ void transpose_item(const float* W, int K, int N, bf16* WT, int k0, int n0, int drow, LAS float* scr, int lane, const float* gk = nullptr) {
#pragma unroll 8
    for (int i = 0; i < 32; ++i) { const int kk = 2 * i + (lane >> 5); scr[kk * 33 + (lane & 31)] = W[(size_t)(k0 + kk) * N + n0 + (lane & 31)] * (gk ? gk[k0 + kk] : 1.f); }
    LDS_WAIT(); asm volatile("" ::: "memory");
    const int c = lane & 7;
#pragma unroll
    for (int j = 0; j < 4; ++j) { const int n = (lane >> 3) + 8 * j; const LAS float* s = scr + (8 * c) * 33 + n;
        v4u o; o.x = pk2(s[0 * 33], s[1 * 33]); o.y = pk2(s[2 * 33], s[3 * 33]); o.z = pk2(s[4 * 33], s[5 * 33]); o.w = pk2(s[6 * 33], s[7 * 33]);
        *(v4u*)(WT + (size_t)(drow + n) * K + k0 + 8 * c) = o; }
    LDS_WAIT(); asm volatile("" ::: "memory");
}
template <bool WF32, bool WBF16> __device__ __forceinline__ void ln_row(f32x4 (&v)[4], float* orow, bf16* brow, const f32x4 (&g)[4], const f32x4 (&bb)[4], int lane) {
    float s = 0.f;
#pragma unroll
    for (int j = 0; j < 4; ++j) s += (v[j].x + v[j].y) + (v[j].z + v[j].w);
    const float mean = wave_sum(s, lane) * (1.f / DM); float s2 = 0.f;
#pragma unroll
    for (int j = 0; j < 4; ++j) { v[j] = v[j] - mean; s2 += (v[j].x * v[j].x + v[j].y * v[j].y) + (v[j].z * v[j].z + v[j].w * v[j].w); }
    const float rstd = 1.f / sqrtf(wave_sum(s2, lane) * (1.f / DM) + LN_EPS);
#pragma unroll
    for (int j = 0; j < 4; ++j) { const f32x4 y = v[j] * rstd * g[j] + bb[j];
        if (WF32) ((f32x4*)orow + lane)[64 * j] = y;
        if (WBF16) ((unsigned long long*)brow + lane)[64 * j] = (unsigned long long)pk2(y.x, y.y) | ((unsigned long long)pk2(y.z, y.w) << 32); }
}
template <bool WF32, bool WBF16> __device__ __forceinline__ void ln_rows(const float* in, float* out, bf16* xn, const float* g, const float* b, int gw, int NGW, int lane) {
    f32x4 gv[4], bv[4];
#pragma unroll
    for (int j = 0; j < 4; ++j) { gv[j] = ((const f32x4*)g + lane)[64 * j]; bv[j] = ((const f32x4*)b + lane)[64 * j]; }
    f32x4 cur[4], nxt[4];
    if (gw < MTOK) {
#pragma unroll
        for (int j = 0; j < 4; ++j) cur[j] = ((const f32x4*)(in + (size_t)gw * DM) + lane)[64 * j]; }
    for (int m = gw; m < MTOK; m += NGW) {
        const int mn = m + NGW;
        if (mn < MTOK) {
#pragma unroll
            for (int j = 0; j < 4; ++j) nxt[j] = ((const f32x4*)(in + (size_t)mn * DM) + lane)[64 * j]; }
        ln_row<WF32, WBF16>(cur, out + (size_t)m * DM, xn + (size_t)m * DM, gv, bv, lane);
#pragma unroll
        for (int j = 0; j < 4; ++j) cur[j] = nxt[j];
    }
}

struct Args { const float* in[23]; float* out; unsigned char* ws; };
__global__ void __launch_bounds__(NWAVES * 64, 2) fwd_kernel(Args args) {
    extern __shared__ __attribute__((aligned(16))) unsigned char lds_raw[];
    cg::grid_group grid = cg::this_grid();
    LAS unsigned char* lds = (LAS unsigned char*)lds_raw;
    const int wave = __builtin_amdgcn_readfirstlane(threadIdx.x >> 6);
#define OPAQUE_TID(name) int name = threadIdx.x; asm volatile("" : "+v"(name))
    const int G = gridDim.x, bx = blockIdx.x, vcu = (G % 8 == 0) ? (bx % 8) * (G / 8) + bx / 8 : bx;
    const int gw = vcu * NWAVES + wave, NGW = G * NWAVES;
    unsigned char* ws = args.ws;
    volatile LAS unsigned* xst = (volatile LAS unsigned*)(lds + LDS_BYTES - 64);
    if (threadIdx.x < 2) xst[threadIdx.x] = 0u;
    __syncthreads();
    const XcdBarrier xbar = xcd_barrier_post((unsigned*)(ws + WS_BAR), xst);
    const float* x = args.in[0]; const float* p = args.in[1];
    float* out = args.out;
    bf16* W_in = (bf16*)(ws + WS_WIN); bf16* W_out = (bf16*)(ws + WS_WOUT); bf16* W_gu = (bf16*)(ws + WS_WGU); bf16* W_dn = (bf16*)(ws + WS_WDN); bf16* W_pg = (bf16*)(ws + WS_WPG); bf16* W_pp = (bf16*)(ws + WS_WPP);
    float* rope = (float*)(ws + WS_ROPE); float* csbw = (float*)(ws + WS_CS);
    pg8::f32x2* st0 = (pg8::f32x2*)(ws + WS_ST0); pg8::f32x2* st1 = (pg8::f32x2*)(ws + WS_ST1); pg8::f32x2* st2 = (pg8::f32x2*)(ws + WS_ST2); pg8::f32x2* st3 = (pg8::f32x2*)(ws + WS_ST3);
    bf16* XN = (bf16*)(ws + WS_XN); bf16* QKV = (bf16*)(ws + WS_QKV); bf16* HID = (bf16*)(ws + WS_HID); bf16* MIX = (bf16*)(ws + WS_MIX); bf16* PB = (bf16*)(ws + WS_PB); bf16* EB = (bf16*)(ws + WS_E);

#ifndef NO_P0
    {
        OPAQUE_TID(tid); const int lane = tid & 63;
        if (bx == 0 && tid < 23) ((const float**)(ws + WS_TBL))[tid] = args.in[tid];
        LAS float* scr = (LAS float*)(lds + wave * 16384);
        constexpr int I_IN = 16 * 96, I_OUT = 16 * 32, I_G = 16 * 88, I_U = 16 * 88, I_DN = 44 * 32, I_PG = 16 * 32, I_PP = 4 * 32;
        constexpr int NITEMS = I_IN + I_OUT + I_G + I_U + I_DN + I_PG + I_PP;
        for (int it = gw; it < NITEMS; it += NGW) {
            int r = it;
            if (r < I_IN) { const int kb = r / 96, nb = r % 96, n0 = 32 * nb; const int drow = (n0 & ~255) + 128 * ((n0 >> 5) & 1) + 32 * ((n0 >> 6) & 3);
                transpose_item(args.in[4], 1024, 3072, W_in, 64 * kb, n0, drow, scr, lane, args.in[2]); continue; } r -= I_IN;
            if (r < I_OUT) { const int kb = r / 32, nb = r % 32; transpose_item(args.in[10], 1024, 1024, W_out, 64 * kb, 32 * nb, 32 * nb, scr, lane); continue; } r -= I_OUT;
            if (r < I_G) { const int kb = r / 88, nb = r % 88, n0 = 32 * nb; transpose_item(args.in[13], 1024, 2816, W_gu, 64 * kb, n0, 256 * (n0 >> 7) + (n0 & 127), scr, lane, args.in[11]); continue; } r -= I_G;
            if (r < I_U) { const int kb = r / 88, nb = r % 88, n0 = 32 * nb; transpose_item(args.in[14], 1024, 2816, W_gu, 64 * kb, n0, 256 * (n0 >> 7) + 128 + (n0 & 127), scr, lane, args.in[11]); continue; } r -= I_U;
            if (r < I_DN) { const int kb = r / 32, nb = r % 32; transpose_item(args.in[15], 2816, 1024, W_dn, 64 * kb, 32 * nb, 32 * nb, scr, lane); continue; } r -= I_DN;
            if (r < I_PG) { const int kb = r / 32, nb = r % 32; transpose_item(args.in[18], 1024, 1024, W_pg, 64 * kb, 32 * nb, 32 * nb, scr, lane, args.in[16]); continue; } r -= I_PG;
            { const int kb = r / 32, nb = r % 32; transpose_item(args.in[20], 256, 1024, W_pp, 64 * kb, 32 * nb, 32 * nb, scr, lane); }
        }
        for (int e = bx * (NWAVES * 64) + tid; e < SEQ * 32; e += G * NWAVES * 64) {
            const int pos = e >> 5, j = e & 31;
            double inv = 1.0; for (int k = 0; k < j; ++k) inv *= 0.74989420933245582730;
            const double a = (double)pos * (double)(float)inv, rev = a * 0.15915494309189533577; const float fr = (float)(rev - floor(rev));
            rope[pos * 64 + j] = __builtin_amdgcn_cosf(fr); rope[pos * 64 + 32 + j] = __builtin_amdgcn_sinf(fr);
        }
        for (int m = gw; m < MTOK; m += 4 * NGW) {
            f32x4 v[4];
#pragma unroll
            for (int q = 0; q < 4; ++q) if (m + q * NGW < MTOK) v[q] = ((const f32x4*)(p + (size_t)(m + q * NGW) * PLE))[lane];
#pragma unroll
            for (int q = 0; q < 4; ++q) if (m + q * NGW < MTOK) ((unsigned long long*)(PB + (size_t)(m + q * NGW) * PLE))[lane] = (unsigned long long)pk2(v[q].x, v[q].y) | ((unsigned long long)pk2(v[q].z, v[q].w) << 32);
        }
        for (int it = (gw + NGW - (NITEMS % NGW)) % NGW; it < 152 * 8; it += NGW) {
            const int cb = it >> 3, kc = (it & 7) * 128;
            const float* W; const float* gk; const float* bk; int N, n, idx, co, bo;
            if (cb < 48) { W = args.in[4]; N = 3072; n = 64 * cb + lane; gk = args.in[2]; bk = args.in[3]; idx = (n & ~255) + 128 * ((n >> 5) & 1) + 32 * ((n >> 6) & 3) + (n & 31); co = CS_IN; bo = BW_IN; }
            else if (cb < 92) { W = args.in[13]; N = 2816; n = 64 * (cb - 48) + lane; gk = args.in[11]; bk = args.in[12]; idx = 256 * (n >> 7) + (n & 127); co = CS_GU; bo = BW_GU; }
            else if (cb < 136) { W = args.in[14]; N = 2816; n = 64 * (cb - 92) + lane; gk = args.in[11]; bk = args.in[12]; idx = 256 * (n >> 7) + 128 + (n & 127); co = CS_GU; bo = BW_GU; }
            else { W = args.in[18]; N = 1024; n = 64 * (cb - 136) + lane; gk = args.in[16]; bk = args.in[17]; idx = n; co = CS_PG; bo = BW_PG; }
            float a0 = 0.f, a1 = 0.f, c0 = 0.f, c1 = 0.f;
#pragma unroll 8
            for (int k = kc; k < kc + 128; k += 2) { const float w0 = W[(size_t)k * N + n], w1 = W[(size_t)(k + 1) * N + n];
                a0 += __uint_as_float(f2bf(gk[k] * w0) << 16); a1 += __uint_as_float(f2bf(gk[k + 1] * w1) << 16); c0 += bk[k] * w0; c1 += bk[k + 1] * w1; }
            atomicAdd(csbw + co + idx, a0 + a1); atomicAdd(csbw + bo + idx, c0 + c1);
        }
        f32x4 v[4], nx[4];
        if (gw < MTOK) {
#pragma unroll
            for (int j = 0; j < 4; ++j) v[j] = ((const f32x4*)(x + (size_t)gw * DM) + lane)[64 * j]; }
        for (int m = gw; m < MTOK; m += NGW) {
            const int mn = m + NGW;
            if (mn < MTOK) {
#pragma unroll
                for (int j = 0; j < 4; ++j) nx[j] = ((const f32x4*)(x + (size_t)mn * DM) + lane)[64 * j]; }
            float s1 = 0.f;
#pragma unroll
            for (int j = 0; j < 4; ++j) s1 += (v[j].x + v[j].y) + (v[j].z + v[j].w);
            const float mean = wave_sum(s1, lane) * (1.f / DM); float s2 = 0.f;
#pragma unroll
            for (int j = 0; j < 4; ++j) { const f32x4 d = v[j] - mean; s2 += (d.x * d.x + d.y * d.y) + (d.z * d.z + d.w * d.w); }
            const float rstd = 1.f / sqrtf(wave_sum(s2, lane) * (1.f / DM) + LN_EPS);
#pragma unroll
            for (int j = 0; j < 4; ++j) { const f32x4 y = (v[j] - mean) * rstd; ((unsigned long long*)(XN + (size_t)m * DM) + lane)[64 * j] = (unsigned long long)pk2(y.x, y.y) | ((unsigned long long)pk2(y.z, y.w) << 32); }
#pragma unroll
            for (int j = 0; j < 4; ++j) v[j] = nx[j];
            if (lane == 0) st0[m] = (pg8::f32x2){mean, rstd};
            if (lane == 1) st1[m] = (pg8::f32x2){0.f, 0.f};
            if (lane == 2) st2[m] = (pg8::f32x2){0.f, 0.f};
            if (lane == 3) st3[m] = (pg8::f32x2){0.f, 0.f};
        }
    }
#endif
    if (args.ws == nullptr) grid.sync();
    xcd_barrier(xbar);
#ifndef NO_P1
    {
        { pg8::Gemm g{XN, W_in, MTOK, NIN, DM}; pg8::StaticOrder S; S.init(MTOK, NIN, G, bx); pg8::EpiQKV E{ws};
          pg8::gemm_phase<pg8::EpiQKV, pg8::StaticOrder, true, true>(lds, g, S, E); }
        __syncthreads();
        { int kpp = PLE; asm volatile("" : "+s"(kpp));
          pg8::Gemm g{PB, W_pp, MTOK, DM, kpp}; pg8::StaticOrder S; S.init(MTOK, DM, G, bx); pg8::EpiPlain E{EB};
          pg8::gemm_phase<pg8::EpiPlain, pg8::StaticOrder, true, true>(lds, g, S, E); }
    }
#endif
    xcd_barrier(xbar);
#ifndef NO_P2
    {
        float lam;
        { OPAQUE_TID(tid); const int lane = tid & 63; const float a = args.in[5][lane] * args.in[6][lane], c = args.in[7][lane] * args.in[8][lane];
          lam = __uint_as_float(__builtin_amdgcn_readfirstlane(__float_as_uint(expf(wave_sum(a, lane)) - expf(wave_sum(c, lane)) + LAMBDA_INIT))); }
        { bool pre = false;
          for (int pu = vcu; pu < BATCH * 4 * 8; pu += G) {
            const int bh = pu >> 3, j = pu & 7;
#pragma nounroll
            for (int k2 = 0; k2 < 2; ++k2) {
                const int pun = pu + G; const bool has_next = (k2 == 0) || (pun < BATCH * 4 * 8);
                const int nbh = k2 == 0 ? bh : (pun >> 3), nblk = k2 == 0 ? j : 15 - (pun & 7);
                if (wave < 4) att::attnA_unit<false>(bh >> 2, bh & 3, k2 ? j : 15 - j, (const att::bf16*)QKV, (att::bf16*)MIX, (att::lds_ptr)lds, lam, args.in[9], pre, has_next, nbh >> 2, nbh & 3, nblk);
                else att::attnA_unit<true>(bh >> 2, bh & 3, k2 ? j : 15 - j, (const att::bf16*)QKV, (att::bf16*)MIX, (att::lds_ptr)lds, lam, args.in[9], pre, has_next, nbh >> 2, nbh & 3, nblk);
                pre = has_next;
            }
          } }
        __syncthreads();
        att::attnB_wave(gw, NGW, BATCH * 8 * 64, (const att::bf16*)QKV, (att::bf16*)MIX, (att::lds_ptr)lds + wave * 16384);
    }
#endif
    xcd_barrier(xbar);
#ifndef NO_P3
    { pg8::Gemm g{MIX, W_out, MTOK, DM, DM}; pg8::StaticOrder S; S.init(MTOK, DM, G, bx); pg8::EpiResidLN<true> E{ws};
      pg8::gemm_phase<pg8::EpiResidLN<true>, pg8::StaticOrder, true, true>(lds, g, S, E); }
#endif
    xcd_barrier(xbar);
#ifndef NO_P4
    { pg8::Gemm g{XN, W_gu, MTOK, NGU, DM}; pg8::StaticOrder S; S.init(MTOK, NGU, G, bx); pg8::EpiSwiGLU E{ws};
      pg8::gemm_phase<pg8::EpiSwiGLU, pg8::StaticOrder, true, true>(lds, g, S, E); }
    xcd_barrier(xbar);
    { pg8::Gemm g{HID, W_dn, MTOK, DM, DFF}; pg8::StaticOrder S; S.init(MTOK, DM, G, bx); pg8::EpiResidLN<false> E{ws};
      pg8::gemm_phase<pg8::EpiResidLN<false>, pg8::StaticOrder, true, true>(lds, g, S, E); }
#endif
    xcd_barrier(xbar);
#ifndef NO_P6
    { pg8::Gemm g{XN, W_pg, MTOK, DM, DM}; pg8::StaticOrder S; S.init(MTOK, DM, G, bx); pg8::EpiPle E{ws};
      pg8::gemm_phase<pg8::EpiPle, pg8::StaticOrder, true, true>(lds, g, S, E); }
    xcd_barrier(xbar);
    {
        OPAQUE_TID(tid); const int lane = tid & 63;
        f32x4 gv[4], bv[4];
#pragma unroll
        for (int hf = 0; hf < 2; ++hf)
#pragma unroll
            for (int q = 0; q < 2; ++q) { gv[2 * hf + q] = *(const f32x4*)(args.in[21] + 512 * hf + 8 * lane + 4 * q); bv[2 * hf + q] = *(const f32x4*)(args.in[22] + 512 * hf + 8 * lane + 4 * q); }
        for (int m = gw; m < MTOK; m += 2 * NGW) {
            const int m2 = m + NGW; const bool two = m2 < MTOK;
            const bf16* yr = MIX + (size_t)m * DM + 8 * lane; const bf16* yr2 = MIX + (size_t)(two ? m2 : m) * DM + 8 * lane;
            const pg8::u32x4 ra0 = *(const pg8::u32x4*)(yr), ra1 = *(const pg8::u32x4*)(yr + 512), rb0 = *(const pg8::u32x4*)(yr2), rb1 = *(const pg8::u32x4*)(yr2 + 512);
            const pg8::f32x2 ms = pg8::row_stats<false>(st3, m), ms2 = pg8::row_stats<false>(st3, two ? m2 : m);
            { float* orow = out + (size_t)m * DM + 8 * lane; f32x4 a, b2;
              pg8::unpack8(ra0, a, b2); *(f32x4*)(orow) = (a - ms.x) * ms.y * gv[0] + bv[0]; *(f32x4*)(orow + 4) = (b2 - ms.x) * ms.y * gv[1] + bv[1];
              pg8::unpack8(ra1, a, b2); *(f32x4*)(orow + 512) = (a - ms.x) * ms.y * gv[2] + bv[2]; *(f32x4*)(orow + 516) = (b2 - ms.x) * ms.y * gv[3] + bv[3]; }
            if (two) { float* orow = out + (size_t)m2 * DM + 8 * lane; f32x4 a, b2;
              pg8::unpack8(rb0, a, b2); *(f32x4*)(orow) = (a - ms2.x) * ms2.y * gv[0] + bv[0]; *(f32x4*)(orow + 4) = (b2 - ms2.x) * ms2.y * gv[1] + bv[1];
              pg8::unpack8(rb1, a, b2); *(f32x4*)(orow + 512) = (a - ms2.x) * ms2.y * gv[2] + bv[2]; *(f32x4*)(orow + 516) = (b2 - ms2.x) * ms2.y * gv[3] + bv[3]; }
        }
    }
#endif
}

extern "C" void kernel_launch(void* const* d_in, const int* in_sizes, int n_in, void* d_out, int out_size, void* d_ws, size_t ws_size, hipStream_t stream) {
    static int grid = 0;
    if (grid == 0) {
        if (n_in != 23 || out_size != MTOK * DM || ws_size < WS_END) { fprintf(stderr, "kernel_launch: unexpected problem (n_in %d, out %d, ws %zu)\n", n_in, out_size, ws_size); grid = -1; return; }
        int dev = 0, cus = 0, per_cu = 0;
        (void)hipGetDevice(&dev); (void)hipDeviceGetAttribute(&cus, hipDeviceAttributeMultiprocessorCount, dev);
        if (hipFuncSetAttribute((const void*)fwd_kernel, hipFuncAttributeMaxDynamicSharedMemorySize, LDS_BYTES) != hipSuccess) { fprintf(stderr, "kernel_launch: hipFuncSetAttribute failed\n"); grid = -1; return; }
        if (hipOccupancyMaxActiveBlocksPerMultiprocessor(&per_cu, (const void*)fwd_kernel, NWAVES * 64, LDS_BYTES) != hipSuccess || per_cu < 1) { fprintf(stderr, "kernel_launch: occupancy query says %d\n", per_cu); per_cu = 1; }
        (void)hipGetLastError();
        grid = cus * per_cu;
        fprintf(stderr, "kernel_launch: grid %d (cus %d x %d)\n", grid, cus, per_cu);
    }
    if (grid < 0) return;
    if (hipMemsetAsync((char*)d_ws + WS_CS, 0, (WS_BAR - WS_CS) + 16384, stream) != hipSuccess) { fprintf(stderr, "kernel_launch: hipMemsetAsync failed\n"); return; }
    Args a{};
    for (int i = 0; i < 23; ++i) a.in[i] = (const float*)d_in[i];
    a.out = (float*)d_out; a.ws = (unsigned char*)d_ws;
    void* kargs[] = {&a};
    const hipError_t e = hipLaunchCooperativeKernel((const void*)fwd_kernel, dim3(grid), dim3(NWAVES * 64), kargs, LDS_BYTES, stream);
    if (e != hipSuccess) fprintf(stderr, "kernel_launch: cooperative launch failed: %s (grid %d)\n", hipGetErrorString(e), grid);
}
```
